# Optimizing an MI355X kernel written in HIP

```python
import math
import jax, jax.numpy as jnp
from jax import lax
import numpy as np

D_MODEL = 4096
BATCH = 2
SEQ = 4096
DEPTH = 1

MEM_LEN = 256
RET_HEADS = 8
RET_DK = 128
RET_DV = 256
RET_CHUNK = 128
ATT_HEADS = 8
ATT_DH = 128
IDX_HEADS = 16
IDX_DH = 64
TOPK_MAX = 256
Q_BLOCK = 128
MEM_HEADS = 4
MEM_DH = 256
REL_BUCKETS = 32
REL_MAX_DIST = 128
PEER_HEADS = 8
PEER_NKEYS = 128
PEER_NEXPERTS = PEER_NKEYS * PEER_NKEYS
PEER_DQ = 256
PEER_TOPK = 16
PEER_BLOCK = 64
N_BRANCHES = 3
EPS = 1e-6
ROPE_BASE = 10000.0

RET_QK_W = RET_HEADS * RET_DK
RET_V_W = RET_HEADS * RET_DV
ATT_Q_W = ATT_HEADS * ATT_DH
IDX_Q_W = IDX_HEADS * IDX_DH
MEM_Q_W = MEM_HEADS * MEM_DH
GATE_W = N_BRANCHES * D_MODEL
SPLIT_SIZES = (RET_QK_W, RET_QK_W, RET_V_W, RET_V_W, ATT_Q_W, ATT_DH, ATT_DH, IDX_Q_W, IDX_DH, IDX_HEADS, MEM_Q_W, GATE_W)
IN_WIDTH = sum(SPLIT_SIZES)
SPLIT_POINTS = tuple(int(v) for v in np.cumsum(SPLIT_SIZES)[:-1])

kernel_name = "hybrid_retention_dsa_memory_peer_block"


def _rms(x):
    xf = x.astype(jnp.float32)
    return xf * lax.rsqrt(jnp.mean(xf * xf, axis=-1, keepdims=True) + EPS)


def rms_norm(x, g):
    return (_rms(x) * g.astype(jnp.float32)).astype(x.dtype)


def rotary(x, pos):
    half = x.shape[-1] // 2
    inv_freq = 1.0 / (ROPE_BASE ** (jnp.arange(half, dtype=jnp.float32) / half))
    ang = pos.astype(jnp.float32)[:, :, None] * inv_freq
    cos = jnp.cos(ang)[:, :, None, :]
    sin = jnp.sin(ang)[:, :, None, :]
    xf = x.astype(jnp.float32)
    x1, x2 = xf[..., :half], xf[..., half:]
    return jnp.concatenate([x1 * cos - x2 * sin, x1 * sin + x2 * cos], axis=-1)


def retention(q, k, v):
    B, S, H, dk = q.shape
    dv = v.shape[-1]
    C = RET_CHUNK
    n = S // C
    log_gamma = jnp.log1p(-jnp.exp2(-5.0 - jnp.arange(H, dtype=jnp.float32)))
    idx = jnp.arange(C, dtype=jnp.float32)
    diff = idx[:, None] - idx[None, :]
    inner_decay = jnp.where(diff[None] >= 0, jnp.exp(log_gamma[:, None, None] * jnp.maximum(diff, 0.0)[None]), 0.0)
    q_decay = jnp.exp(log_gamma[:, None] * (idx + 1.0)[None])
    k_decay = jnp.exp(log_gamma[:, None] * (C - 1.0 - idx)[None])
    chunk_decay = jnp.exp(log_gamma * C)
    qf = q.astype(jnp.float32)
    kf = k.astype(jnp.float32) * (dk ** -0.5)
    vf = v.astype(jnp.float32)
    qc = qf.reshape(B, n, C, H, dk).transpose(1, 0, 3, 2, 4)
    kc = kf.reshape(B, n, C, H, dk).transpose(1, 0, 3, 2, 4)
    vc = vf.reshape(B, n, C, H, dv).transpose(1, 0, 3, 2, 4)

    def step(state, inp):
        qi, ki, vi = inp
        scores = jnp.einsum('bhid,bhjd->bhij', qi, ki) * inner_decay
        inner = jnp.einsum('bhij,bhjv->bhiv', scores, vi)
        cross = jnp.einsum('bhid,bhdv->bhiv', qi * q_decay[None, :, :, None], state)
        state = state * chunk_decay[None, :, None, None] + jnp.einsum('bhjd,bhjv->bhdv', ki * k_decay[None, :, :, None], vi)
        return state, inner + cross

    state0 = jnp.zeros((B, H, dk, dv), jnp.float32)
    _, out = lax.scan(step, state0, (qc, kc, vc))
    return out.transpose(1, 0, 3, 2, 4).reshape(B, S, H, dv)


def t5_bucket(dist):
    n = jnp.maximum(dist, 0)
    max_exact = REL_BUCKETS // 2
    large = max_exact + (jnp.log(jnp.maximum(n, 1).astype(jnp.float32) / max_exact)
                         / math.log(REL_MAX_DIST / max_exact) * (REL_BUCKETS - max_exact)).astype(jnp.int32)
    large = jnp.minimum(large, REL_BUCKETS - 1)
    return jnp.where(n < max_exact, n, large)


def sparse_attention(q, k, v, iq, ik, iw, pos, rel_bias):
    B, S, H, dh = q.shape
    topk = min(TOPK_MAX, S // 4)
    nblk = S // Q_BLOCK
    iw = iw * (IDX_HEADS ** -0.5)

    def gather_rows(table, ids):
        return table[ids]

    def block(bi):
        start = bi * Q_BLOCK
        qb = lax.dynamic_slice_in_dim(q, start, Q_BLOCK, axis=1)
        iqb = lax.dynamic_slice_in_dim(iq, start, Q_BLOCK, axis=1)
        iwb = lax.dynamic_slice_in_dim(iw, start, Q_BLOCK, axis=1)
        pb = lax.dynamic_slice_in_dim(pos, start, Q_BLOCK, axis=1)
        ilog = jnp.einsum('bthd,bsd->bths', iqb, ik) * (IDX_DH ** -0.5)
        score = jnp.einsum('bth,bths->bts', iwb, jax.nn.relu(ilog)).astype(jnp.float32)
        causal = pos[:, None, :] <= pb[:, :, None]
        score = jnp.where(causal, score, -jnp.inf)
        _, sel = lax.top_k(score, topk)
        k_sel = jax.vmap(gather_rows)(k, sel)
        v_sel = jax.vmap(gather_rows)(v, sel)
        p_sel = jax.vmap(gather_rows)(pos, sel)
        dist = pb[:, :, None] - p_sel
        valid = dist >= 0
        bias = rel_bias[t5_bucket(dist)].astype(jnp.float32)
        logits = jnp.einsum('bthd,btkd->bhtk', qb, k_sel).astype(jnp.float32) * (dh ** -0.5)
        logits = logits + bias.transpose(0, 3, 1, 2)
        logits = jnp.where(valid[:, None], logits, -jnp.inf)
        p = jax.nn.softmax(logits, axis=-1).astype(v.dtype)
        return jnp.einsum('bhtk,btkd->bthd', p, v_sel)

    outs = lax.map(block, jnp.arange(nblk))
    return outs.transpose(1, 0, 2, 3, 4).reshape(B, S, H * dh)


def memory_attention(mq, mem, mem_g, w_kv, q_g, k_g):
    B, M, _ = mem.shape
    S = mq.shape[1]
    kv = rms_norm(mem, mem_g) @ w_kv
    mk, mv = jnp.split(kv, 2, axis=-1)
    mk = rms_norm(mk.reshape(B, M, MEM_HEADS, MEM_DH), k_g)
    mv = mv.reshape(B, M, MEM_HEADS, MEM_DH)
    mq = rms_norm(mq, q_g)
    logits = jnp.einsum('bshd,bmhd->bhsm', mq, mk).astype(jnp.float32) * (MEM_DH ** -0.5)
    p = jax.nn.softmax(logits, axis=-1).astype(mv.dtype)
    return jnp.einsum('bhsm,bmhd->bshd', p, mv).reshape(B, S, MEM_Q_W)


def peer(x, w_q, sub_keys, u_tab, v_tab):
    B, S, D = x.shape
    T = B * S
    K = PEER_TOPK
    xt = x.reshape(T, D)
    q = (xt @ w_q).reshape(T, PEER_HEADS, 2, PEER_DQ // 2)
    s = jnp.einsum('thcd,hcnd->thcn', q, sub_keys).astype(jnp.float32)
    sv, si = lax.top_k(s, K)
    cand = (sv[:, :, 0, :, None] + sv[:, :, 1, None, :]).reshape(T, PEER_HEADS, K * K)
    cand_idx = (si[:, :, 0, :, None] * PEER_NKEYS + si[:, :, 1, None, :]).reshape(T, PEER_HEADS, K * K)
    top_v, top_pos = lax.top_k(cand, K)
    eidx = jnp.take_along_axis(cand_idx, top_pos, axis=-1).reshape(T, PEER_HEADS * K)
    gate = jax.nn.softmax(top_v, axis=-1).reshape(T, PEER_HEADS * K).astype(x.dtype)
    nblk = T // PEER_BLOCK

    def block(inp):
        xb, ib, gb = inp
        act = jax.nn.gelu(jnp.einsum('td,ted->te', xb, u_tab[ib]), approximate=False)
        return jnp.einsum('te,ted->td', act * gb, v_tab[ib])

    out = lax.map(block, (xt.reshape(nblk, PEER_BLOCK, D),
                          eidx.reshape(nblk, PEER_BLOCK, PEER_HEADS * K),
                          gate.reshape(nblk, PEER_BLOCK, PEER_HEADS * K)))
    return out.reshape(B, S, D)


def setup_inputs(seed: int = 0) -> dict:
    key = jax.random.key(seed)
    ks = jax.random.split(key, 24)
    D = D_MODEL
    L = DEPTH
    f32 = jnp.float32

    def nrm(k, shape, scale):
        return jax.random.normal(k, shape, f32) * scale

    def gain(k, shape):
        return 1.0 + 0.02 * jax.random.normal(k, shape, f32)

    start = jax.random.randint(ks[2], (BATCH,), 0, 1024, dtype=jnp.int32)
    positions = (start[:, None] + jnp.arange(SEQ, dtype=jnp.int32)[None, :]).astype(jnp.int32)
    return {
        "x": nrm(ks[0], (BATCH, SEQ, D), 1.0),
        "mem": nrm(ks[1], (BATCH, MEM_LEN, D), 1.0),
        "positions": positions,
        "ln1_g": gain(ks[3], (L, D)),
        "w_in": nrm(ks[4], (L, D, IN_WIDTH), D ** -0.5),
        "att_q_g": gain(ks[5], (L, ATT_DH)),
        "att_k_g": gain(ks[6], (L, ATT_DH)),
        "rel_bias": nrm(ks[7], (REL_BUCKETS, ATT_HEADS), 0.5),
        "mem_g": gain(ks[8], (L, D)),
        "w_mem_kv": nrm(ks[9], (L, D, 2 * MEM_Q_W), D ** -0.5),
        "mem_q_g": gain(ks[10], (L, MEM_DH)),
        "mem_k_g": gain(ks[11], (L, MEM_DH)),
        "w_up_ret": nrm(ks[12], (L, RET_V_W, D), RET_V_W ** -0.5),
        "w_up_att": nrm(ks[13], (L, ATT_Q_W, D), ATT_Q_W ** -0.5),
        "w_up_mem": nrm(ks[14], (L, MEM_Q_W, D), MEM_Q_W ** -0.5),
        "w_out": nrm(ks[15], (L, D, D), D ** -0.5),
        "ln2_g": gain(ks[16], (L, D)),
        "peer_w_q": nrm(ks[17], (L, D, PEER_HEADS * PEER_DQ), D ** -0.5),
        "peer_sub_keys": nrm(ks[18], (L, PEER_HEADS, 2, PEER_NKEYS, PEER_DQ // 2), (PEER_DQ // 2) ** -0.5),
        "peer_u": nrm(ks[19], (L, PEER_NEXPERTS, D), D ** -0.5),
        "peer_v": nrm(ks[20], (L, PEER_NEXPERTS, D), 0.5),
    }


def reference(x, mem, positions, ln1_g, w_in, att_q_g, att_k_g, rel_bias, mem_g, w_mem_kv, mem_q_g, mem_k_g,
              w_up_ret, w_up_att, w_up_mem, w_out, ln2_g, peer_w_q, peer_sub_keys, peer_u, peer_v):
    B, S, D = x.shape
    for l in range(DEPTH):
        h = rms_norm(x, ln1_g[l])
        proj = h @ w_in[l]
        rq, rk, rv, rg, aq, ak, av, iq, ik, iw, mq, gates = jnp.split(proj, SPLIT_POINTS, axis=-1)
        rq = rotary(rq.reshape(B, S, RET_HEADS, RET_DK), positions)
        rk = rotary(rk.reshape(B, S, RET_HEADS, RET_DK), positions)
        ret = retention(rq, rk, rv.reshape(B, S, RET_HEADS, RET_DV))
        ret = _rms(ret).reshape(B, S, RET_V_W).astype(x.dtype)
        y_ret = jax.nn.silu(rg) * ret
        aq = rms_norm(aq.reshape(B, S, ATT_HEADS, ATT_DH), att_q_g[l])
        ak = rms_norm(ak, att_k_g[l])
        y_att = sparse_attention(aq, ak, av, iq.reshape(B, S, IDX_HEADS, IDX_DH), ik, iw, positions, rel_bias)
        y_mem = memory_attention(mq.reshape(B, S, MEM_HEADS, MEM_DH), mem, mem_g[l], w_mem_kv[l], mem_q_g[l], mem_k_g[l])
        g = jax.nn.sigmoid(gates.reshape(B, S, N_BRANCHES, D))
        merged = (g[:, :, 0] * (y_ret @ w_up_ret[l])
                  + g[:, :, 1] * (y_att @ w_up_att[l])
                  + g[:, :, 2] * (y_mem @ w_up_mem[l]))
        x = x + merged @ w_out[l]
        x = x + peer(rms_norm(x, ln2_g[l]), peer_w_q[l], peer_sub_keys[l], peer_u[l], peer_v[l])
    return x
```

```cpp
#include <hip/hip_runtime.h>
#include <cstdio>
#include <cstdint>
namespace pg8 {
#define PG8_LAS __attribute__((address_space(3)))
typedef unsigned short bf16_t;
typedef short bf16x8 __attribute__((ext_vector_type(8)));
typedef float f32x4 __attribute__((ext_vector_type(4)));
typedef unsigned u32x4 __attribute__((ext_vector_type(4)));
constexpr int BM = 256, BK = 64, HALF = 128, HTB = HALF * BK * 2  , STAGE_BYTES = 8 * HTB, NXCD = 8, WGM = 8;

__host__ __device__ __forceinline__ int lds_byte(int r, int c) { const int st = (r >> 4) * 2 + (c >> 5), rr = r & 15, cc = c & 31, ob = rr * 64 + cc * 2; return st * 1024 + (ob ^ (((ob >> 9) & 1) << 5)); }
__host__ __device__ __forceinline__ void stage_rc(int b, int& R, int& C) { const int st = b / 1024, sb = b % 1024, swz = sb ^ (((sb >> 9) & 1) << 5); R = (st >> 1) * 16 + swz / 64; C = (st & 1) * 32 + (swz % 64) / 2; }
__host__ __device__ __forceinline__ int perm32(int rho) { const int n = rho >> 4, i = rho & 15; return 8 * (i >> 2) + 4 * n + (i & 3); }

struct Unit { int pm, pn, kt0, nkt, keep; };
struct Gemm { const bf16_t* A; const bf16_t* Bt; int M, N, K; };

struct StaticOrder {
    int nM, nN, nwg, G, c;
    __host__ __device__ void init(int M, int N, int G_, int c_) { nM = M / BM; nN = N / BM; nwg = nM * nN; G = G_; c = c_; }
    __host__ __device__ __forceinline__ bool next(int i, Unit& u) const {
        const long L = (long)i * G + c; if (L >= nwg) return false;
        int wgid = (int)L; { const int q = nwg / NXCD, r = nwg % NXCD, xcd = wgid % NXCD, off = wgid / NXCD; wgid = (xcd < r ? xcd * (q + 1) : r * (q + 1) + (xcd - r) * q) + off; }
        const int nig = WGM * nN, gid = wgid / nig, fm = gid * WGM, gsz = (nM - fm) < WGM ? (nM - fm) : WGM;
        u.pm = fm + ((wgid % nig) % gsz); u.pn = (wgid % nig) / gsz; u.kt0 = 0; u.nkt = 64; u.keep = 0; return true;
    }
    __device__ __forceinline__ void a_ready(const Unit&) const {}
    __device__ __forceinline__ void done(const Unit&) const {}
};

__device__ __forceinline__ unsigned cvt_pk_bf16(float lo, float hi) { unsigned r; asm volatile("v_cvt_pk_bf16_f32 %0, %1, %2" : "=v"(r) : "v"(lo), "v"(hi)); return r; }
__device__ __forceinline__ void store_tile_bf16(const f32x4 (&acc)[2][2][4][2], bf16_t* base, int ldc, int row0, int col0) {
#pragma unroll
    for (int ai = 0; ai < 2; ++ai)
#pragma unroll
        for (int m = 0; m < 4; ++m) { bf16_t* rowp = base + (size_t)(row0 + ai * HALF + m * 16) * ldc + col0;
#pragma unroll
            for (int bj = 0; bj < 2; ++bj) { const f32x4 v0 = acc[ai][bj][m][0], v1 = acc[ai][bj][m][1];
                u32x4 w; w.x = cvt_pk_bf16(v0[0], v0[1]); w.y = cvt_pk_bf16(v0[2], v0[3]); w.z = cvt_pk_bf16(v1[0], v1[1]); w.w = cvt_pk_bf16(v1[2], v1[3]);
                *(u32x4*)(rowp + bj * HALF) = w; } }
}
struct OrderP1a {
    StaticOrder so;
    __device__ void init(int G, int c) { so.init(8192, 6144, G, c); }
    __device__ bool next(int i, Unit& u) const { if (!so.next(i, u)) return false; u.pn += 32; return true; }
    __device__ __forceinline__ void a_ready(const Unit&) const {}
    __device__ __forceinline__ void done(const Unit&) const {}
};
struct EpiP1a {
    static constexpr bool PERM = true, AFTER_DRAIN = false;
    bf16_t* proj;
    __device__ __forceinline__ void operator()(const f32x4 (&acc)[2][2][4][2], const Unit& u, int wr, int wc, int fr, int fq) const {
        store_tile_bf16(acc, proj, 22016, u.pm * 256 + wr * 64 + fr, (u.pn - 32) * 256 + wc * 32 + 8 * fq);
    }
};
struct OrderP1b {
    StaticOrder so;
    __device__ void init(int G, int c) { so.init(8192, 22016, G, c); }
    __device__ bool next(int i, Unit& u) const {
        const long L = (long)i * so.G + so.c;
        if (L < so.nwg) { so.next(i, u); u.pn += 34; u.nkt = 32; return true; }
        const int e = (int)(L - so.nwg); if (e >= 16) return false;
        if (e < 8) { u.pm = 32 + (e & 1); u.pn = 120 + (e >> 1); } else { u.pm = 124 + ((e - 8) >> 1); u.pn = 32 + ((e - 8) & 1); }
        u.kt0 = 0; u.nkt = 32; u.keep = 0; return true;
    }
    __device__ __forceinline__ void a_ready(const Unit&) const {}
    __device__ __forceinline__ void done(const Unit&) const {}
};
struct EpiP1b {
    static constexpr bool PERM = true, AFTER_DRAIN = false;
    bf16_t *proj, *mk, *mvT; unsigned char* sg; const PG8_LAS unsigned char* lut;
    __device__ __forceinline__ static unsigned sig_u8_exact(float g) {
        const float s = __builtin_amdgcn_rcpf(1.f + __expf(-g)); unsigned q = (unsigned)__builtin_fmaf(s, 255.f, 0.5f); return q < 1u ? 1u : (q > 255u ? 255u : q); }
    __device__ __forceinline__ unsigned sig_u8(float g) const {
        const float fi = __builtin_amdgcn_fmed3f(__builtin_fmaf(g, 256.f, 2048.5f), 0.f, 4096.f); return (unsigned)lut[(int)fi]; }
    __device__ __forceinline__ void operator()(const f32x4 (&acc)[2][2][4][2], const Unit& u, int wr, int wc, int fr, int fq) const {
        if (u.pm >= 32) {
            bf16_t* base; int ldc, r0, c0;
            if (u.pm < 34) { base = mk; ldc = 1024; r0 = (u.pm - 32) * 256; c0 = (u.pn - 120) * 256; }
            else { base = mvT; ldc = 512; r0 = (u.pm - 124) * 256; c0 = (u.pn - 32) * 256; }
            store_tile_bf16(acc, base, ldc, r0 + wr * 64 + fr, c0 + wc * 32 + 8 * fq);
            return;
        }
        const int row0 = u.pm * 256 + wr * 64 + fr, col0 = (u.pn - 34) * 256 + wc * 32 + 8 * fq;
#pragma unroll
        for (int bj = 0; bj < 2; ++bj) { const int cg = col0 + bj * HALF;
            if (cg < 9552) {
#pragma unroll
                for (int ai = 0; ai < 2; ++ai)
#pragma unroll
                    for (int m = 0; m < 4; ++m) { const f32x4 v0 = acc[ai][bj][m][0], v1 = acc[ai][bj][m][1];
                        u32x4 w; w.x = cvt_pk_bf16(v0[0], v0[1]); w.y = cvt_pk_bf16(v0[2], v0[3]); w.z = cvt_pk_bf16(v1[0], v1[1]); w.w = cvt_pk_bf16(v1[2], v1[3]);
                        *(u32x4*)(proj + (size_t)(row0 + ai * HALF + m * 16) * 22016 + cg) = w; }
            } else if (cg < 21840) {
                const int gi = (cg - 9552) >> 12, gc = (cg - 9552) & 4095;
                unsigned char* sp = sg + ((size_t)gi * 8192 + row0) * 4096 + gc;
#pragma unroll
                for (int ai = 0; ai < 2; ++ai)
#pragma unroll
                    for (int m = 0; m < 4; ++m) { const f32x4 v0 = acc[ai][bj][m][0], v1 = acc[ai][bj][m][1];
                        typedef unsigned u32x2g __attribute__((ext_vector_type(2))); u32x2g w;
                        w.x = sig_u8(v0[0]) | (sig_u8(v0[1]) << 8) | (sig_u8(v0[2]) << 16) | (sig_u8(v0[3]) << 24);
                        w.y = sig_u8(v1[0]) | (sig_u8(v1[1]) << 8) | (sig_u8(v1[2]) << 16) | (sig_u8(v1[3]) << 24);
                        *(u32x2g*)(sp + (size_t)(ai * HALF + m * 16) * 4096) = w; }
            }
        }
    }
};
struct OrderUp {
    StaticOrder so;
    __device__ void init(int G, int c) { so.init(8192, 4096, G, c); }
    __device__ bool next(int i, Unit& u) const {
        const int round = i / 3, br = i - 3 * round;
        if (!so.next(round, u)) return false;
        u.kt0 = br == 0 ? 0 : (br == 1 ? 32 : 48); u.nkt = br == 0 ? 32 : 16; u.keep = br < 2 ? 1 : 0; return true;
    }
    __device__ __forceinline__ void a_ready(const Unit&) const {}
    __device__ __forceinline__ void done(const Unit&) const {}
};
struct EpiUp {
    static constexpr bool PERM = true, AFTER_DRAIN = false;
    const unsigned char* __restrict__ sg; bf16_t* __restrict__ merged;
    typedef unsigned u32x2g __attribute__((ext_vector_type(2)));
    mutable u32x2g keep[2][4][2];
    __device__ __forceinline__ void operator()(const f32x4 (&acc_in)[2][2][4][2], const Unit& u, int wr, int wc, int fr, int fq) const {
        f32x4 (&acc)[2][2][4][2] = const_cast<f32x4 (&)[2][2][4][2]>(acc_in);
        const int mode = u.kt0 == 0 ? 0 : (u.kt0 == 32 ? 1 : 2);
        const int row0 = u.pm * 256 + wr * 64 + fr, col0 = u.pn * 256 + wc * 32 + 8 * fq;
        const unsigned char* pa = sg + (size_t)row0 * 4096 + col0;
        const unsigned char* pb = sg + ((size_t)(mode < 2 ? mode + 1 : 2) * 8192 + row0) * 4096 + col0;
#pragma unroll
        for (int ai = 0; ai < 2; ++ai) {
            u32x2g ga[4][2], gb[4][2];
#pragma unroll
            for (int m = 0; m < 4; ++m)
#pragma unroll
                for (int bj = 0; bj < 2; ++bj) { const size_t off = (size_t)(ai * HALF + m * 16) * 4096 + bj * HALF;
                    ga[m][bj] = keep[ai][m][bj]; gb[m][bj] = keep[ai][m][bj];
                    if (mode == 0) ga[m][bj] = *(const u32x2g*)(pa + off);
                    if (mode < 2) gb[m][bj] = *(const u32x2g*)(pb + off); }
#pragma unroll
            for (int m = 0; m < 4; ++m)
#pragma unroll
                for (int bj = 0; bj < 2; ++bj) {
                    float f[8];
                    if (mode < 2) {
#pragma unroll
                        for (int e = 0; e < 8; ++e) { const float a = (float)((ga[m][bj][e >> 2] >> (8 * (e & 3))) & 0xffu), b = (float)((gb[m][bj][e >> 2] >> (8 * (e & 3))) & 0xffu);
                            f[e] = a * __builtin_amdgcn_rcpf(b); }
                    } else {
#pragma unroll
                        for (int e = 0; e < 8; ++e) f[e] = (float)((ga[m][bj][e >> 2] >> (8 * (e & 3))) & 0xffu) * (1.f / 255.f);
                    }
                    keep[ai][m][bj] = gb[m][bj];
                    f32x4 v0 = acc[ai][bj][m][0], v1 = acc[ai][bj][m][1];
                    v0[0] *= f[0]; v0[1] *= f[1]; v0[2] *= f[2]; v0[3] *= f[3]; v1[0] *= f[4]; v1[1] *= f[5]; v1[2] *= f[6]; v1[3] *= f[7];
                    acc[ai][bj][m][0] = v0; acc[ai][bj][m][1] = v1;
                    if (mode == 2) { u32x4 w; w.x = cvt_pk_bf16(v0[0], v0[1]); w.y = cvt_pk_bf16(v0[2], v0[3]); w.z = cvt_pk_bf16(v1[0], v1[1]); w.w = cvt_pk_bf16(v1[2], v1[3]);
                        *(u32x4*)(merged + (size_t)(row0 + ai * HALF + m * 16) * 4096 + col0 + bj * HALF) = w; } }
            asm volatile("" ::: "memory"); }
    }
};
struct EpiResF32 {
    static constexpr bool PERM = false, AFTER_DRAIN = false;
    const float* __restrict__ X; bf16_t* __restrict__ C; float* __restrict__ part; unsigned char* __restrict__ XN8;
    __device__ __forceinline__ void operator()(const f32x4 (&acc)[2][2][4][2], const Unit& u, int wr, int wc, int fr, int fq) const {
        const int row0 = u.pm * BM + wr * 64 + fr, col0 = u.pn * BM + wc * 32 + 4 * fq;
#pragma unroll
        for (int am = 0; am < 4; ++am) { const int ai = am >> 1;
            f32x4 xv[4][2][2];
#pragma unroll
            for (int m = 2 * (am & 1); m < 2 * (am & 1) + 2; ++m) { const size_t off = (size_t)(row0 + ai * HALF + m * 16) * 4096 + col0;
#pragma unroll
                for (int bj = 0; bj < 2; ++bj)
#pragma unroll
                    for (int n = 0; n < 2; ++n) xv[m][bj][n] = *(const f32x4*)(X + off + bj * HALF + n * 16); }
#pragma unroll
            for (int m = 2 * (am & 1); m < 2 * (am & 1) + 2; ++m) { const int row = row0 + ai * HALF + m * 16; const size_t off = (size_t)row * 4096 + col0; float ss = 0.f;
#pragma unroll
                for (int bj = 0; bj < 2; ++bj)
#pragma unroll
                    for (int n = 0; n < 2; ++n) { const f32x4 x1 = acc[ai][bj][m][n] + xv[m][bj][n];
                        typedef unsigned u32x2v __attribute__((ext_vector_type(2))); u32x2v w; w.x = cvt_pk_bf16(x1[0], x1[1]); w.y = cvt_pk_bf16(x1[2], x1[3]);
                        *(u32x2v*)(C + off + bj * HALF + n * 16) = w;
                        ss += (x1[0] * x1[0] + x1[1] * x1[1]) + (x1[2] * x1[2] + x1[3] * x1[3]);
                        int w8 = __builtin_amdgcn_cvt_pk_fp8_f32(x1[0], x1[1], 0, false); w8 = __builtin_amdgcn_cvt_pk_fp8_f32(x1[2], x1[3], w8, true); *(int*)(XN8 + off + bj * HALF + n * 16) = w8; }
                ss += __shfl_xor(ss, 16); ss += __shfl_xor(ss, 32);
                if (fq == 0) part[(size_t)row * 64 + u.pn * 4 + wc] = ss; }
        }
    }
};
struct EpiStoreBf16Rs {
    static constexpr bool PERM = true, AFTER_DRAIN = false;
    bf16_t* __restrict__ O; int ldc; const float* __restrict__ part;
    __device__ __forceinline__ void operator()(const f32x4 (&acc_in)[2][2][4][2], const Unit& u, int wr, int wc, int fr, int fq) const {
        f32x4 (&acc)[2][2][4][2] = const_cast<f32x4 (&)[2][2][4][2]>(acc_in);
#pragma unroll
        for (int ai = 0; ai < 2; ++ai) {
            f32x4 pv[4][4];
#pragma unroll
            for (int m = 0; m < 4; ++m) { const float* pp = part + (size_t)(u.pm * 256 + ai * HALF + wr * 64 + m * 16 + fr) * 64 + 16 * fq;
#pragma unroll
                for (int j = 0; j < 4; ++j) pv[m][j] = *(const f32x4*)(pp + 4 * j); }
#pragma unroll
            for (int m = 0; m < 4; ++m) { const f32x4 s4 = (pv[m][0] + pv[m][1]) + (pv[m][2] + pv[m][3]);
                float ss = (s4[0] + s4[1]) + (s4[2] + s4[3]); ss += __shfl_xor(ss, 16); ss += __shfl_xor(ss, 32);
                const float rs = rsqrtf(ss * (1.f / 4096.f) + 1e-6f);
#pragma unroll
                for (int bj = 0; bj < 2; ++bj)
#pragma unroll
                    for (int n = 0; n < 2; ++n) acc[ai][bj][m][n] = acc[ai][bj][m][n] * rs; }
        }
        store_tile_bf16(acc, O, ldc, u.pm * 256 + wr * 64 + fr, u.pn * 256 + wc * 32 + 8 * fq);
    }
};
template <class Epi, class Sched, bool ALIGN_EPI = false, bool SP2 = false>
__device__ __forceinline__ void gemm_phase(PG8_LAS unsigned char* lds, const Gemm g, const Sched& S, const Epi& E) {
    const int tid = threadIdx.x, wid = __builtin_amdgcn_readfirstlane(tid >> 6), lane = tid & 63, wr = wid >> 2, wc = wid & 3, fr = lane & 15, fq = lane >> 4;
    const int K = g.K;
    unsigned voffA[2], voffB[2];
#pragma unroll
    for (int i = 0; i < 2; ++i) { int R, C; stage_rc(tid * 16 + i * 8192, R, C); const int Rb = Epi::PERM ? ((R & ~31) + perm32(R & 31)) : R;
        voffA[i] = (unsigned)(R * K + C) * 2u; voffB[i] = (unsigned)(Rb * K + C) * 2u; }
    const size_t kstep = (size_t)(BK * 2);
    const size_t hstep = (size_t)HALF * K * 2;
    const size_t tstep = 2 * hstep;
    const unsigned ldsw = (unsigned)wid * 1024u;
    const int aoff = lds_byte(wr * 64 + fr, fq * 8), boff = lds_byte(wc * 32 + fr, fq * 8);
#define PG8_SA(b, h) (((b) * 2 + (h)) * HTB)
#define PG8_SB(b, h) ((4 + (b) * 2 + (h)) * HTB)
#define PG8_STAGE(bufoff, gbase, voff) do { _Pragma("unroll") for (int _i = 0; _i < 2; ++_i) \
        __builtin_amdgcn_global_load_lds((const unsigned*)((const char*)(gbase) + (voff)[_i]), (PG8_LAS unsigned*)(lds + (bufoff) + ldsw + _i * 8192), 16, 0, 0); } while (0)
#define PG8_LDA(dst, b, h) do { _Pragma("unroll") for (int m = 0; m < 4; ++m) _Pragma("unroll") for (int k = 0; k < 2; ++k) dst[m][k] = *(const PG8_LAS bf16x8*)(lds + PG8_SA(b, h) + aoff + m * 2048 + k * 1024); } while (0)
#define PG8_LDB(dst, b, h) do { _Pragma("unroll") for (int n = 0; n < 2; ++n) _Pragma("unroll") for (int k = 0; k < 2; ++k) dst[n][k] = *(const PG8_LAS bf16x8*)(lds + PG8_SB(b, h) + boff + n * 2048 + k * 1024); } while (0)
#define PG8_MMA(ai, bj, At, Bt) do { __builtin_amdgcn_s_setprio(1); _Pragma("unroll") for (int m = 0; m < 4; ++m) _Pragma("unroll") for (int n = 0; n < 2; ++n) _Pragma("unroll") for (int k = 0; k < 2; ++k) \
        acc[ai][bj][m][n] = __builtin_amdgcn_mfma_f32_16x16x32_bf16(Bt[n][k], At[m][k], acc[ai][bj][m][n], 0, 0, 0); __builtin_amdgcn_s_setprio(0); } while (0)
#define PG8_WAIT_V(n) asm volatile("s_waitcnt vmcnt(" #n ")" ::: "memory")
#define PG8_WAIT_L(n) asm volatile("s_waitcnt lgkmcnt(" #n ")" ::: "memory")
#define PG8_BAR __builtin_amdgcn_s_barrier()
#define PG8_SCHED __builtin_amdgcn_sched_barrier(0)
    Unit cur, nxt; int ui = 0;
    if (!S.next(0, cur)) return;
    f32x4 acc[2][2][4][2];
#pragma unroll
    for (int a = 0; a < 2; ++a)
#pragma unroll
        for (int b = 0; b < 2; ++b)
#pragma unroll
            for (int m = 0; m < 4; ++m)
#pragma unroll
                for (int n = 0; n < 2; ++n) acc[a][b][m][n] = (f32x4){0.f, 0.f, 0.f, 0.f};
    bf16x8 At[4][2], B0[2][2], B1[2][2];
    const char* cA = (const char*)g.A + (size_t)cur.pm * tstep + (size_t)cur.kt0 * (size_t)(BK * 2); const char* cB = (const char*)g.Bt + (size_t)cur.pn * tstep + (size_t)cur.kt0 * (size_t)(BK * 2);
    S.a_ready(cur);
    if constexpr (SP2) {
        PG8_STAGE(PG8_SB(0, 0), cB, voffB); PG8_STAGE(PG8_SB(0, 1), cB + hstep, voffB); PG8_STAGE(PG8_SA(0, 0), cA, voffA); PG8_STAGE(PG8_SA(0, 1), cA + hstep, voffA);
        if (wr == 1) PG8_BAR;
        PG8_WAIT_V(2); PG8_BAR;
        PG8_STAGE(PG8_SB(1, 0), cB + kstep, voffB); PG8_STAGE(PG8_SA(1, 0), cA + kstep, voffA); PG8_STAGE(PG8_SB(1, 1), cB + hstep + kstep, voffB);
        PG8_WAIT_V(6); PG8_BAR;
    } else {
        PG8_STAGE(PG8_SB(0, 0), cB, voffB); PG8_STAGE(PG8_SA(0, 0), cA, voffA); PG8_STAGE(PG8_SB(0, 1), cB + hstep, voffB); PG8_STAGE(PG8_SA(0, 1), cA + hstep, voffA);
        if (wr == 1) PG8_BAR;
        PG8_WAIT_V(4); PG8_BAR;
        PG8_STAGE(PG8_SB(1, 0), cB + kstep, voffB); PG8_STAGE(PG8_SA(1, 0), cA + kstep, voffA); PG8_STAGE(PG8_SB(1, 1), cB + hstep + kstep, voffB);
        PG8_WAIT_V(6); PG8_BAR;
    }
    for (;;) {
        const bool has_next = S.next(ui + 1, nxt);
        const char* nA = has_next ? (const char*)g.A + (size_t)nxt.pm * tstep + (size_t)nxt.kt0 * kstep : cA; const char* nB = has_next ? (const char*)g.Bt + (size_t)nxt.pn * tstep + (size_t)nxt.kt0 * kstep : cB;
        const int nt = cur.nkt;
        for (int t = 0; t < nt; t += 2) {
            const bool last = (t == nt - 2);
            const char* a1 = cA + (size_t)(t + 1) * kstep;
            const char* a2 = last ? nA : cA + (size_t)(t + 2) * kstep; const char* b2 = last ? nB : cB + (size_t)(t + 2) * kstep;
            const char* a3 = a2 + kstep; const char* b3 = b2 + kstep;
            if (last && has_next) S.a_ready(nxt);
            if constexpr (SP2) {
            PG8_LDB(B0, 0, 0); PG8_LDB(B1, 0, 1); PG8_SCHED; PG8_LDA(At, 0, 0); PG8_STAGE(PG8_SA(1, 1), a1 + hstep, voffA);
            PG8_WAIT_V(8); PG8_WAIT_L(0); PG8_BAR; PG8_MMA(0, 0, At, B0); PG8_MMA(0, 1, At, B1); PG8_BAR; PG8_SCHED;
            PG8_LDA(At, 0, 1); PG8_STAGE(PG8_SB(0, 0), b2, voffB); PG8_STAGE(PG8_SB(0, 1), b2 + hstep, voffB); PG8_STAGE(PG8_SA(0, 0), a2, voffA);
            PG8_WAIT_V(8); PG8_WAIT_L(0); PG8_BAR; PG8_MMA(1, 0, At, B0); PG8_MMA(1, 1, At, B1); PG8_BAR; PG8_SCHED;
            PG8_LDB(B0, 1, 0); PG8_LDB(B1, 1, 1); PG8_SCHED; PG8_LDA(At, 1, 0); PG8_STAGE(PG8_SA(0, 1), a2 + hstep, voffA);
            PG8_WAIT_V(8); PG8_WAIT_L(0); PG8_BAR; PG8_MMA(0, 0, At, B0); PG8_MMA(0, 1, At, B1); PG8_BAR; PG8_SCHED;
            PG8_LDA(At, 1, 1); PG8_STAGE(PG8_SB(1, 0), b3, voffB); PG8_STAGE(PG8_SB(1, 1), b3 + hstep, voffB); PG8_STAGE(PG8_SA(1, 0), a3, voffA);
            PG8_WAIT_V(8); PG8_WAIT_L(0); PG8_BAR; PG8_MMA(1, 0, At, B0); PG8_MMA(1, 1, At, B1); PG8_BAR; PG8_SCHED;
            } else {
            PG8_LDB(B0, 0, 0); PG8_SCHED; PG8_LDA(At, 0, 0); PG8_STAGE(PG8_SA(1, 1), a1 + hstep, voffA);
            PG8_WAIT_L(8); PG8_BAR; PG8_WAIT_L(0); PG8_MMA(0, 0, At, B0); PG8_BAR; PG8_SCHED;
            PG8_LDB(B1, 0, 1); PG8_STAGE(PG8_SB(0, 0), b2, voffB);
            PG8_BAR; PG8_WAIT_L(0); PG8_MMA(0, 1, At, B1); PG8_BAR;
            PG8_LDA(At, 0, 1); PG8_STAGE(PG8_SA(0, 0), a2, voffA);
            PG8_BAR; PG8_WAIT_L(0); PG8_MMA(1, 0, At, B0); PG8_BAR; PG8_SCHED;
            PG8_STAGE(PG8_SB(0, 1), b2 + hstep, voffB);
            PG8_WAIT_V(6); PG8_BAR; PG8_MMA(1, 1, At, B1); PG8_BAR;
            PG8_LDB(B0, 1, 0); PG8_SCHED; PG8_LDA(At, 1, 0); PG8_STAGE(PG8_SA(0, 1), a2 + hstep, voffA);
            PG8_WAIT_L(8); PG8_BAR; PG8_WAIT_L(0); PG8_MMA(0, 0, At, B0); PG8_BAR; PG8_SCHED;
            PG8_LDB(B1, 1, 1); PG8_STAGE(PG8_SB(1, 0), b3, voffB);
            PG8_BAR; PG8_WAIT_L(0); PG8_MMA(0, 1, At, B1); PG8_BAR;
            PG8_LDA(At, 1, 1); PG8_STAGE(PG8_SA(1, 0), a3, voffA);
            PG8_BAR; PG8_WAIT_L(0); PG8_MMA(1, 0, At, B0); PG8_BAR; PG8_SCHED;
            PG8_STAGE(PG8_SB(1, 1), b3 + hstep, voffB);
            PG8_WAIT_V(6); PG8_BAR; PG8_MMA(1, 1, At, B1); PG8_BAR;
            }
        }
        if constexpr (ALIGN_EPI) { if (wr == 0) PG8_BAR; }
        if constexpr (!Epi::AFTER_DRAIN) { E(acc, cur, wr, wc, fr, fq); S.done(cur); }
        if (!has_next) break;
        if (!cur.keep) {
#pragma unroll
        for (int a = 0; a < 2; ++a)
#pragma unroll
            for (int b = 0; b < 2; ++b)
#pragma unroll
                for (int m = 0; m < 4; ++m)
#pragma unroll
                    for (int n = 0; n < 2; ++n) acc[a][b][m][n] = (f32x4){0.f, 0.f, 0.f, 0.f};
        }
        cur = nxt; cA = nA; cB = nB; ++ui;
        if constexpr (ALIGN_EPI) { if (wr == 1) PG8_BAR; }
    }
    PG8_WAIT_V(0);
    if constexpr (!ALIGN_EPI) { if (wr == 0) PG8_BAR; }
    PG8_BAR;
    if constexpr (Epi::AFTER_DRAIN) { E.fused(acc, cur, wr, wc, fr, fq, lds, wid, lane); S.done(cur); }
#undef PG8_SA
#undef PG8_SB
#undef PG8_STAGE
#undef PG8_LDA
#undef PG8_LDB
#undef PG8_MMA
#undef PG8_WAIT_V
#undef PG8_WAIT_L
#undef PG8_BAR
#undef PG8_SCHED
}
typedef int i32x4 __attribute__((ext_vector_type(4)));
typedef int i32x8 __attribute__((ext_vector_type(8)));
template <class Epi, class Sched, bool ALIGN_EPI = false, bool SP2 = false>
__device__ __forceinline__ void gemm_phase_f8(PG8_LAS unsigned char* lds, const Gemm g, const Sched& S, const Epi& E) {
    const int tid = threadIdx.x, wid = __builtin_amdgcn_readfirstlane(tid >> 6), lane = tid & 63, wr = wid >> 2, wc = wid & 3, fr = lane & 15, fq = lane >> 4;
    const int K = g.K;
    unsigned voffA[2], voffB[2];
#pragma unroll
    for (int i = 0; i < 2; ++i) { int R, C; stage_rc(tid * 16 + i * 8192, R, C); const int Rb = Epi::PERM ? ((R & ~31) + perm32(R & 31)) : R;
        voffA[i] = (unsigned)(R * K + 2 * C); voffB[i] = (unsigned)(Rb * K + 2 * C); }
    const size_t kstep = (size_t)(BK * 2);
    const size_t hstep = (size_t)HALF * K;
    const size_t tstep = 2 * hstep;
    const unsigned ldsw = (unsigned)wid * 1024u;
    const int aoff = lds_byte(wr * 64 + fr, fq * 8), boff = lds_byte(wc * 32 + fr, fq * 8);
#define PG8_SA(b, h) (((b) * 2 + (h)) * HTB)
#define PG8_SB(b, h) ((4 + (b) * 2 + (h)) * HTB)
#define PG8_STAGE(bufoff, gbase, voff) do { _Pragma("unroll") for (int _i = 0; _i < 2; ++_i) \
        __builtin_amdgcn_global_load_lds((const unsigned*)((const char*)(gbase) + (voff)[_i]), (PG8_LAS unsigned*)(lds + (bufoff) + ldsw + _i * 8192), 16, 0, 0); } while (0)
#define PG8_LDA(dst, b, h) do { _Pragma("unroll") for (int m = 0; m < 4; ++m) { const i32x4 lo_ = *(const PG8_LAS i32x4*)(lds + PG8_SA(b, h) + aoff + m * 2048), hi_ = *(const PG8_LAS i32x4*)(lds + PG8_SA(b, h) + aoff + m * 2048 + 1024); dst[m] = __builtin_shufflevector(lo_, hi_, 0, 1, 2, 3, 4, 5, 6, 7); } } while (0)
#define PG8_LDB(dst, b, h) do { _Pragma("unroll") for (int n = 0; n < 2; ++n) { const i32x4 lo_ = *(const PG8_LAS i32x4*)(lds + PG8_SB(b, h) + boff + n * 2048), hi_ = *(const PG8_LAS i32x4*)(lds + PG8_SB(b, h) + boff + n * 2048 + 1024); dst[n] = __builtin_shufflevector(lo_, hi_, 0, 1, 2, 3, 4, 5, 6, 7); } } while (0)
#define PG8_MMA(ai, bj, At, Bt) do { __builtin_amdgcn_s_setprio(1); _Pragma("unroll") for (int m = 0; m < 4; ++m) _Pragma("unroll") for (int n = 0; n < 2; ++n) \
        asm volatile("v_mfma_scale_f32_16x16x128_f8f6f4 %0, %1, %2, %0, %3, %4 op_sel_hi:[0,0,0]" : "+v"(acc[ai][bj][m][n]) : "v"(Bt[n]), "v"(At[m]), "v"(sc_w), "v"(sc_1)); __builtin_amdgcn_s_setprio(0); } while (0)
#define PG8_WAIT_V(n) asm volatile("s_waitcnt vmcnt(" #n ")" ::: "memory")
#define PG8_WAIT_L(n) asm volatile("s_waitcnt lgkmcnt(" #n ")" ::: "memory")
#define PG8_BAR __builtin_amdgcn_s_barrier()
#define PG8_SCHED __builtin_amdgcn_sched_barrier(0)
    Unit cur, nxt; int ui = 0;
    if (!S.next(0, cur)) return;
    f32x4 acc[2][2][4][2];
#pragma unroll
    for (int a = 0; a < 2; ++a)
#pragma unroll
        for (int b = 0; b < 2; ++b)
#pragma unroll
            for (int m = 0; m < 4; ++m)
#pragma unroll
                for (int n = 0; n < 2; ++n) acc[a][b][m][n] = (f32x4){0.f, 0.f, 0.f, 0.f};
    i32x8 At[4], B0[2], B1[2];
    const int sc_w = 0x79797979, sc_1 = 0x7F7F7F7F;
    const char* cA = (const char*)g.A + (size_t)cur.pm * tstep + (size_t)cur.kt0 * (size_t)(BK * 2); const char* cB = (const char*)g.Bt + (size_t)cur.pn * tstep + (size_t)cur.kt0 * (size_t)(BK * 2);
    S.a_ready(cur);
    if constexpr (SP2) {
        PG8_STAGE(PG8_SB(0, 0), cB, voffB); PG8_STAGE(PG8_SB(0, 1), cB + hstep, voffB); PG8_STAGE(PG8_SA(0, 0), cA, voffA); PG8_STAGE(PG8_SA(0, 1), cA + hstep, voffA);
        if (wr == 1) PG8_BAR;
        PG8_WAIT_V(2); PG8_BAR;
        PG8_STAGE(PG8_SB(1, 0), cB + kstep, voffB); PG8_STAGE(PG8_SA(1, 0), cA + kstep, voffA); PG8_STAGE(PG8_SB(1, 1), cB + hstep + kstep, voffB);
        PG8_WAIT_V(6); PG8_BAR;
    } else {
        PG8_STAGE(PG8_SB(0, 0), cB, voffB); PG8_STAGE(PG8_SA(0, 0), cA, voffA); PG8_STAGE(PG8_SB(0, 1), cB + hstep, voffB); PG8_STAGE(PG8_SA(0, 1), cA + hstep, voffA);
        if (wr == 1) PG8_BAR;
        PG8_WAIT_V(4); PG8_BAR;
        PG8_STAGE(PG8_SB(1, 0), cB + kstep, voffB); PG8_STAGE(PG8_SA(1, 0), cA + kstep, voffA); PG8_STAGE(PG8_SB(1, 1), cB + hstep + kstep, voffB);
        PG8_WAIT_V(6); PG8_BAR;
    }
    for (;;) {
        const bool has_next = S.next(ui + 1, nxt);
        const char* nA = has_next ? (const char*)g.A + (size_t)nxt.pm * tstep + (size_t)nxt.kt0 * kstep : cA; const char* nB = has_next ? (const char*)g.Bt + (size_t)nxt.pn * tstep + (size_t)nxt.kt0 * kstep : cB;
        const int nt = cur.nkt;
        for (int t = 0; t < nt; t += 2) {
            const bool last = (t == nt - 2);
            const char* a1 = cA + (size_t)(t + 1) * kstep;
            const char* a2 = last ? nA : cA + (size_t)(t + 2) * kstep; const char* b2 = last ? nB : cB + (size_t)(t + 2) * kstep;
            const char* a3 = a2 + kstep; const char* b3 = b2 + kstep;
            if (last && has_next) S.a_ready(nxt);
            if constexpr (SP2) {
            PG8_LDB(B0, 0, 0); PG8_LDB(B1, 0, 1); PG8_SCHED; PG8_LDA(At, 0, 0); PG8_STAGE(PG8_SA(1, 1), a1 + hstep, voffA);
            PG8_WAIT_V(8); PG8_WAIT_L(0); PG8_BAR; PG8_MMA(0, 0, At, B0); PG8_MMA(0, 1, At, B1); PG8_BAR; PG8_SCHED;
            PG8_LDA(At, 0, 1); PG8_STAGE(PG8_SB(0, 0), b2, voffB); PG8_STAGE(PG8_SB(0, 1), b2 + hstep, voffB); PG8_STAGE(PG8_SA(0, 0), a2, voffA);
            PG8_WAIT_V(8); PG8_WAIT_L(0); PG8_BAR; PG8_MMA(1, 0, At, B0); PG8_MMA(1, 1, At, B1); PG8_BAR; PG8_SCHED;
            PG8_LDB(B0, 1, 0); PG8_LDB(B1, 1, 1); PG8_SCHED; PG8_LDA(At, 1, 0); PG8_STAGE(PG8_SA(0, 1), a2 + hstep, voffA);
            PG8_WAIT_V(8); PG8_WAIT_L(0); PG8_BAR; PG8_MMA(0, 0, At, B0); PG8_MMA(0, 1, At, B1); PG8_BAR; PG8_SCHED;
            PG8_LDA(At, 1, 1); PG8_STAGE(PG8_SB(1, 0), b3, voffB); PG8_STAGE(PG8_SB(1, 1), b3 + hstep, voffB); PG8_STAGE(PG8_SA(1, 0), a3, voffA);
            PG8_WAIT_V(8); PG8_WAIT_L(0); PG8_BAR; PG8_MMA(1, 0, At, B0); PG8_MMA(1, 1, At, B1); PG8_BAR; PG8_SCHED;
            } else {
            PG8_LDB(B0, 0, 0); PG8_SCHED; PG8_LDA(At, 0, 0); PG8_STAGE(PG8_SA(1, 1), a1 + hstep, voffA);
            PG8_WAIT_L(8); PG8_BAR; PG8_WAIT_L(0); PG8_MMA(0, 0, At, B0); PG8_BAR; PG8_SCHED;
            PG8_LDB(B1, 0, 1); PG8_STAGE(PG8_SB(0, 0), b2, voffB);
            PG8_BAR; PG8_WAIT_L(0); PG8_MMA(0, 1, At, B1); PG8_BAR;
            PG8_LDA(At, 0, 1); PG8_STAGE(PG8_SA(0, 0), a2, voffA);
            PG8_BAR; PG8_WAIT_L(0); PG8_MMA(1, 0, At, B0); PG8_BAR; PG8_SCHED;
            PG8_STAGE(PG8_SB(0, 1), b2 + hstep, voffB);
            PG8_WAIT_V(6); PG8_BAR; PG8_MMA(1, 1, At, B1); PG8_BAR;
            PG8_LDB(B0, 1, 0); PG8_SCHED; PG8_LDA(At, 1, 0); PG8_STAGE(PG8_SA(0, 1), a2 + hstep, voffA);
            PG8_WAIT_L(8); PG8_BAR; PG8_WAIT_L(0); PG8_MMA(0, 0, At, B0); PG8_BAR; PG8_SCHED;
            PG8_LDB(B1, 1, 1); PG8_STAGE(PG8_SB(1, 0), b3, voffB);
            PG8_BAR; PG8_WAIT_L(0); PG8_MMA(0, 1, At, B1); PG8_BAR;
            PG8_LDA(At, 1, 1); PG8_STAGE(PG8_SA(1, 0), a3, voffA);
            PG8_BAR; PG8_WAIT_L(0); PG8_MMA(1, 0, At, B0); PG8_BAR; PG8_SCHED;
            PG8_STAGE(PG8_SB(1, 1), b3 + hstep, voffB);
            PG8_WAIT_V(6); PG8_BAR; PG8_MMA(1, 1, At, B1); PG8_BAR;
            }
        }
        if constexpr (ALIGN_EPI) { if (wr == 0) PG8_BAR; }
        asm volatile("s_nop 15\n\ts_nop 15\n\ts_nop 15" ::: "memory");
        if constexpr (!Epi::AFTER_DRAIN) { E(acc, cur, wr, wc, fr, fq); S.done(cur); }
        if (!has_next) break;
        if (!cur.keep) {
#pragma unroll
        for (int a = 0; a < 2; ++a)
#pragma unroll
            for (int b = 0; b < 2; ++b)
#pragma unroll
                for (int m = 0; m < 4; ++m)
#pragma unroll
                    for (int n = 0; n < 2; ++n) acc[a][b][m][n] = (f32x4){0.f, 0.f, 0.f, 0.f};
        }
        cur = nxt; cA = nA; cB = nB; ++ui;
        if constexpr (ALIGN_EPI) { if (wr == 1) PG8_BAR; }
    }
    PG8_WAIT_V(0);
    if constexpr (!ALIGN_EPI) { if (wr == 0) PG8_BAR; }
    PG8_BAR;
    if constexpr (Epi::AFTER_DRAIN) { E.fused(acc, cur, wr, wc, fr, fq, lds, wid, lane); S.done(cur); }
#undef PG8_SA
#undef PG8_SB
#undef PG8_STAGE
#undef PG8_LDA
#undef PG8_LDB
#undef PG8_MMA
#undef PG8_WAIT_V
#undef PG8_WAIT_L
#undef PG8_BAR
#undef PG8_SCHED
}
}

constexpr int NB = 2, SEQ = 4096, DM = 4096, NT = NB * SEQ;
constexpr int MEML = 256, NMEM = NB * MEML;
constexpr int LDP = 22016;
constexpr int C_RQ = 0, C_RK = 1024, C_RV = 2048, C_RG = 4096, C_AQ = 6144, C_AK = 7168, C_AV = 7296, C_IQ = 7424, C_IK = 8448, C_IW = 8512, C_MQ = 8528, C_GT = 9552, NPROJ = 21840;
constexpr float EPS = 1e-6f;
constexpr int CONV_R0 = 16384;
constexpr int NWAVES = 8, NTHR = 512;
#ifndef MK_PER_PHASE
#define MK_PER_PHASE 0
#endif
constexpr int NPH = 11;

constexpr size_t MiB = 1u << 20;
constexpr size_t WS_CTL = 0, CTL_ZERO_BYTES = 1 * MiB;
constexpr size_t WS_R = 1 * MiB;
constexpr size_t WS_R8 = WS_R;
constexpr size_t WS_SCORES = WS_R;
constexpr size_t WS_X1B = WS_R;
constexpr size_t WS_SG = 129 * MiB;
constexpr size_t WS_PROJ = 257 * MiB;
constexpr size_t WS_XN2 = WS_PROJ;
constexpr size_t WS_QP = WS_PROJ + 64 * MiB;
constexpr size_t WS_EIDX = WS_PROJ + 96 * MiB;
constexpr size_t WS_EGATE = WS_PROJ + 100 * MiB;
constexpr size_t WS_XN8 = WS_PROJ + 104 * MiB;
constexpr size_t WS_WUP = 601 * MiB, WS_WOUT = 633 * MiB, WS_WQ = 665 * MiB;
constexpr size_t WS_MK = 681 * MiB, WS_MVT = 682 * MiB, WS_MKN = 683 * MiB, WS_SKB = 684 * MiB;
constexpr size_t WS_AQN = 685 * MiB, WS_AKN = 701 * MiB, WS_AVC = 703 * MiB, WS_MQN = 705 * MiB;
constexpr size_t WS_SC = 721 * MiB;
constexpr size_t WS_ST = 785 * MiB;
constexpr size_t WS_IDX = 817 * MiB;
constexpr size_t WS_Y = 821 * MiB;
constexpr size_t WS_MERGED = 885 * MiB;
constexpr size_t WS_U8 = 949 * MiB, WS_V8 = 1013 * MiB;
constexpr int XROW = 2176;
constexpr int XSL = 272;
constexpr size_t XSLICE = (size_t)16384 * XSL;
constexpr size_t WS_END = 1077 * MiB;
constexpr size_t WS_PART = 1050 * MiB;
constexpr int CW_BAR = 4096;

constexpr int LDS_SCR = 155648;
constexpr int LDSCTL_OFF = LDS_SCR;
constexpr int LDS_BYTES = LDS_SCR + 256;

#define GAS __attribute__((address_space(1)))
#define LAS __attribute__((address_space(3)))
typedef unsigned short bf16;
typedef unsigned v4u __attribute__((ext_vector_type(4)));
typedef unsigned v2u __attribute__((ext_vector_type(2)));
typedef short s16x4 __attribute__((ext_vector_type(4)));
using pg8::f32x4; using pg8::bf16x8;
#define LDS_WAIT() asm volatile("s_waitcnt lgkmcnt(0)" ::: "memory")
__device__ __forceinline__ float bflo(unsigned w) { return __uint_as_float(w << 16); }
__device__ __forceinline__ float bfhi(unsigned w) { return __uint_as_float(w & 0xffff0000u); }
__device__ __forceinline__ unsigned f2bf(float f) { unsigned u = __float_as_uint(f); return (u + 0x7fffu + ((u >> 16) & 1u)) >> 16; }
__device__ __forceinline__ unsigned pk2(float lo, float hi) { return f2bf(lo) | (f2bf(hi) << 16); }
__device__ __forceinline__ float wave_sum(float v) {
#pragma unroll
    for (int o = 1; o < 64; o <<= 1) v += __shfl_xor(v, o);
    return v;
}
__device__ __forceinline__ int wave_sum_i(int v) {
#pragma unroll
    for (int o = 1; o < 64; o <<= 1) v += __shfl_xor(v, o);
    return v;
}
template <int CTRL> __device__ __forceinline__ float dpp_f(float v) { return __int_as_float(__builtin_amdgcn_update_dpp(0, __float_as_int(v), CTRL, 0xF, 0xF, true)); }
__device__ __forceinline__ float wave_sum_dpp(float v) {
    v += dpp_f<0xB1>(v); v += dpp_f<0x4E>(v); v += dpp_f<0x141>(v); v += dpp_f<0x140>(v);
    const int iv = __float_as_int(v);
    return (__int_as_float(__builtin_amdgcn_readlane(iv, 0)) + __int_as_float(__builtin_amdgcn_readlane(iv, 16))) + (__int_as_float(__builtin_amdgcn_readlane(iv, 32)) + __int_as_float(__builtin_amdgcn_readlane(iv, 48)));
}
__device__ __forceinline__ f32x4 mfma16(bf16x8 a, bf16x8 b, f32x4 c) { return __builtin_amdgcn_mfma_f32_16x16x32_bf16(a, b, c, 0, 0, 0); }
__device__ __forceinline__ unsigned lds_addr(const LAS unsigned char* p) { return (unsigned)(size_t)p; }
__device__ __forceinline__ bf16x8 tr_read8(unsigned a0, unsigned a1) {
    s16x4 lo, hi;
    asm volatile("ds_read_b64_tr_b16 %0, %2\n\tds_read_b64_tr_b16 %1, %3\n\ts_waitcnt lgkmcnt(0)" : "=&v"(lo), "=&v"(hi) : "v"(a0), "v"(a1) : "memory");
    bf16x8 r; r[0] = lo[0]; r[1] = lo[1]; r[2] = lo[2]; r[3] = lo[3]; r[4] = hi[0]; r[5] = hi[1]; r[6] = hi[2]; r[7] = hi[3]; return r;
}
__device__ __forceinline__ void tr_read8x4(unsigned a0, unsigned a1, bf16x8 (&f)[4]) {
    s16x4 l0, h0, l1, h1, l2, h2, l3, h3;
    asm volatile("ds_read_b64_tr_b16 %0, %8\n\tds_read_b64_tr_b16 %1, %9\n\tds_read_b64_tr_b16 %2, %8 offset:32\n\tds_read_b64_tr_b16 %3, %9 offset:32\n\t"
                 "ds_read_b64_tr_b16 %4, %8 offset:64\n\tds_read_b64_tr_b16 %5, %9 offset:64\n\tds_read_b64_tr_b16 %6, %8 offset:96\n\tds_read_b64_tr_b16 %7, %9 offset:96\n\ts_waitcnt lgkmcnt(0)"
                 : "=&v"(l0), "=&v"(h0), "=&v"(l1), "=&v"(h1), "=&v"(l2), "=&v"(h2), "=&v"(l3), "=&v"(h3) : "v"(a0), "v"(a1) : "memory");
    f[0] = (bf16x8){l0[0], l0[1], l0[2], l0[3], h0[0], h0[1], h0[2], h0[3]}; f[1] = (bf16x8){l1[0], l1[1], l1[2], l1[3], h1[0], h1[1], h1[2], h1[3]};
    f[2] = (bf16x8){l2[0], l2[1], l2[2], l2[3], h2[0], h2[1], h2[2], h2[3]}; f[3] = (bf16x8){l3[0], l3[1], l3[2], l3[3], h3[0], h3[1], h3[2], h3[3]};
}

#define XB_TMO      128
#define XB_XCNT(j)  (256  + 64 * (j))
#define XB_XSUB(j)  (1280 + 64 * (j))
#define XB_XGEN(j)  (2304 + 64 * (j))
#define XB_TOP      3328
#define XB_TOPGEN   3392
#define XCD_BAR_WORDS 3456
#define XB_SPIN_CAP (1u << 22)

__device__ __forceinline__ unsigned xb_ld(unsigned* p)              { return __hip_atomic_load(p, __ATOMIC_RELAXED, __HIP_MEMORY_SCOPE_AGENT); }
__device__ __forceinline__ unsigned xb_add(unsigned* p, unsigned v) { return __hip_atomic_fetch_add(p, v, __ATOMIC_RELAXED, __HIP_MEMORY_SCOPE_AGENT); }
__device__ __forceinline__ unsigned xb_xcc_id() { return (unsigned)__builtin_amdgcn_s_getreg((3 << 11) | 20) & 0xFu; }
#define XB_SPIN(cond, bar) do { unsigned _sp = 0; while (cond) { __builtin_amdgcn_s_sleep(1); \
    if ((++_sp & 255u) == 0u) { if (xb_ld(&(bar)[XB_TMO])) break; if (_sp > XB_SPIN_CAP) { atomicAdd(&(bar)[XB_TMO], 1u); break; } } } } while (0)

struct XcdBarrier {
    unsigned* bar; unsigned x;
    volatile LAS unsigned* st;
};

__device__ __forceinline__ XcdBarrier xcd_barrier_post(unsigned* bar, volatile LAS unsigned* st) {
    XcdBarrier b; b.bar = bar; b.x = xb_xcc_id(); b.st = st;
    if (threadIdx.x == 0) (void)xb_add(&bar[XB_XCNT(b.x)], 1u);
    return b;
}
__device__ __forceinline__ void xcd_barrier_complete(unsigned* bar, unsigned x, unsigned& nloc, unsigned& nx) {
    const unsigned G = gridDim.x * gridDim.y * gridDim.z;
    unsigned sum, cnt, mine, sp = 0u;
    for (;;) {
        sum = 0u; cnt = 0u; mine = 0u;
#pragma unroll
        for (unsigned j = 0; j < 16; ++j) { const unsigned c = xb_ld(&bar[XB_XCNT(j)]); sum += c; cnt += (c > 0u) ? 1u : 0u; mine = (j == x) ? c : mine; }
        if (sum == G) break;
        __builtin_amdgcn_s_sleep(1);
        if ((++sp & 255u) == 0u) { if (xb_ld(&bar[XB_TMO])) break; if (sp > XB_SPIN_CAP) { atomicAdd(&bar[XB_TMO], 1u); break; } }
    }
    nloc = mine > 0u ? mine : 1u; nx = cnt > 0u ? cnt : 1u;
}

__device__ __forceinline__ void xcd_barrier(const XcdBarrier& b) {
    asm volatile("s_waitcnt vmcnt(0)" ::: "memory");
    __syncthreads();
    if (threadIdx.x == 0) {
        unsigned* bar = b.bar;
        __builtin_amdgcn_s_waitcnt(0);
        unsigned nloc = b.st[0], nx = b.st[1];
        if (nloc == 0u) { xcd_barrier_complete(bar, b.x, nloc, nx); b.st[0] = nloc; b.st[1] = nx; }
        const unsigned old = xb_add(&bar[XB_XSUB(b.x)], 1u);
        const unsigned gen = old / nloc;
        if (old + 1u == (gen + 1u) * nloc) {
            __builtin_amdgcn_fence(__ATOMIC_RELEASE, "agent");
            asm volatile("s_waitcnt vmcnt(0)" ::: "memory");
            const unsigned og = xb_add(&bar[XB_TOP], 1u);
            const unsigned tg = og / nx;
            if (og + 1u == (tg + 1u) * nx) xb_add(&bar[XB_TOPGEN], 1u);
            else XB_SPIN(xb_ld(&bar[XB_TOPGEN]) == tg, bar);
            __builtin_amdgcn_fence(__ATOMIC_ACQUIRE, "agent");
            xb_add(&bar[XB_XGEN(b.x)], 1u);
            asm volatile("s_waitcnt vmcnt(0)" ::: "memory");
        } else {
            XB_SPIN(xb_ld(&bar[XB_XGEN(b.x)]) == gen, bar);
            __builtin_amdgcn_fence(__ATOMIC_ACQUIRE, "agent");
            asm volatile("s_waitcnt vmcnt(0)" ::: "memory");
        }
    }
    __syncthreads();
}


struct Params {
    const float *x, *mem; const int* pos;
    const float *ln1_g, *w_in, *att_q_g, *att_k_g, *rel_bias, *mem_g, *w_mem_kv, *mem_q_g, *mem_k_g, *w_up_ret, *w_up_att, *w_up_mem, *w_out, *ln2_g, *peer_w_q, *peer_sub_keys, *peer_u, *peer_v;
    float* out; unsigned char* ws;
    int ph_lo, ph_hi, li, pad;
};
#define WSP(T, off) ((T*)(p.ws + (off)))

__device__ __forceinline__ void transpose_item(const float* W, int N, bf16* WT, int dstK, int row_off, int col_off, int nblk, LAS float* scr, int item, int lane, int ldw = 0, const float* kscale = nullptr) {
    if (ldw == 0) ldw = N;
    const int kb = item / nblk, nb = item - kb * nblk, k0 = 64 * kb, n0 = 64 * nb;
    const int c4 = lane & 15, kr = lane >> 4; const bool ok = (n0 + 4 * c4) < N;
    f32x4 v[16];
#pragma unroll
    for (int i = 0; i < 16; ++i) v[i] = ok ? *(const f32x4*)(W + (size_t)(k0 + 4 * i + kr) * ldw + n0 + 4 * c4) : (f32x4){0.f, 0.f, 0.f, 0.f};
    if (kscale) {
        float ks[16];
#pragma unroll
        for (int i = 0; i < 16; ++i) ks[i] = kscale[k0 + 4 * i + kr];
#pragma unroll
        for (int i = 0; i < 16; ++i) v[i] = v[i] * ks[i];
    }
#pragma unroll
    for (int i = 0; i < 16; ++i) { LAS float* d = scr + (4 * i + kr) * 65 + 4 * c4; d[0] = v[i].x; d[1] = v[i].y; d[2] = v[i].z; d[3] = v[i].w; }
    LDS_WAIT(); asm volatile("" ::: "memory");
    const int c = lane & 7;
#pragma unroll
    for (int j = 0; j < 8; ++j) { const int n = (lane >> 3) + 8 * j; const LAS float* s = scr + (8 * c) * 65 + n;
        v4u o; o.x = pk2(s[0 * 65], s[1 * 65]); o.y = pk2(s[2 * 65], s[3 * 65]); o.z = pk2(s[4 * 65], s[5 * 65]); o.w = pk2(s[6 * 65], s[7 * 65]);
        *(v4u*)(WT + (size_t)(row_off + n0 + n) * dstK + col_off + k0 + 8 * c) = o; }
    LDS_WAIT(); asm volatile("" ::: "memory");
}
__device__ __forceinline__ unsigned pack_fp8x4(f32x4 v, float sc) {
    int w = 0;
    w = __builtin_amdgcn_cvt_pk_fp8_f32(__builtin_amdgcn_fmed3f(v.x * sc, -448.f, 448.f), __builtin_amdgcn_fmed3f(v.y * sc, -448.f, 448.f), w, false);
    w = __builtin_amdgcn_cvt_pk_fp8_f32(__builtin_amdgcn_fmed3f(v.z * sc, -448.f, 448.f), __builtin_amdgcn_fmed3f(v.w * sc, -448.f, 448.f), w, true);
    return (unsigned)w;
}
__device__ __forceinline__ void transpose_item_f8(const float* W, int ldw, int col0, int N, unsigned char* W8, int row_off, int nblk, LAS float* scr, int item, int lane) {
    const int pi = item >> 1, kb2 = pi / nblk, nb = pi - kb2 * nblk, kb = 2 * kb2 + (item & 1), k0 = 64 * kb, n0 = 64 * nb;
    const int c4 = lane & 15, kr = lane >> 4; const bool ok = (n0 + 4 * c4) < N;
    f32x4 v[16];
#pragma unroll
    for (int i = 0; i < 16; ++i) v[i] = ok ? *(const f32x4*)(W + (size_t)(k0 + 4 * i + kr) * ldw + col0 + n0 + 4 * c4) : (f32x4){0.f, 0.f, 0.f, 0.f};
#pragma unroll
    for (int i = 0; i < 16; ++i) { LAS float* d = scr + (4 * i + kr) * 65 + 4 * c4; d[0] = v[i].x; d[1] = v[i].y; d[2] = v[i].z; d[3] = v[i].w; }
    LDS_WAIT(); asm volatile("" ::: "memory");
    const int c = lane & 7;
#pragma unroll
    for (int j = 0; j < 8; ++j) { const int n = (lane >> 3) + 8 * j; const LAS float* s = scr + (8 * c) * 65 + n;
        v2u o; o.x = pack_fp8x4((f32x4){s[0 * 65], s[1 * 65], s[2 * 65], s[3 * 65]}, 64.f); o.y = pack_fp8x4((f32x4){s[4 * 65], s[5 * 65], s[6 * 65], s[7 * 65]}, 64.f);
        *(v2u*)(W8 + (size_t)(row_off + n0 + n) * 4096 + k0 + 8 * c) = o; }
    LDS_WAIT(); asm volatile("" ::: "memory");
}
template <bool BF> __device__ __forceinline__ void rms_row_to_both(const float* xrow, const float* gain, bf16* orow, unsigned char* orow8, int lane) {
    const f32x4* xr = (const f32x4*)xrow + lane; const f32x4* gr = (const f32x4*)gain + lane;
    f32x4 v[16]; float s = 0.f;
#pragma unroll
    for (int j = 0; j < 16; ++j) { v[j] = xr[64 * j]; s += (v[j].x * v[j].x + v[j].y * v[j].y) + (v[j].z * v[j].z + v[j].w * v[j].w); }
    const float r = rsqrtf(wave_sum(s) * (1.f / 4096.f) + EPS);
    v2u* o8 = (v2u*)orow + lane; unsigned* o4 = (unsigned*)orow8 + lane;
#pragma unroll
    for (int j = 0; j < 16; ++j) { const f32x4 g = gr[64 * j]; const f32x4 y = (f32x4){v[j].x * r * g.x, v[j].y * r * g.y, v[j].z * r * g.z, v[j].w * r * g.w};
        if (BF) { v2u o; o.x = pk2(y.x, y.y); o.y = pk2(y.z, y.w); o8[64 * j] = o; } o4[64 * j] = pack_fp8x4(y, 1.f); }
}
__device__ __forceinline__ void rms_row_to_bf16(const float* xrow, const float* gain, bf16* orow, int lane) {
    const f32x4* xr = (const f32x4*)xrow + lane; const f32x4* gr = (const f32x4*)gain + lane;
    f32x4 v[16]; float s = 0.f;
#pragma unroll
    for (int j = 0; j < 16; ++j) { v[j] = xr[64 * j]; s += (v[j].x * v[j].x + v[j].y * v[j].y) + (v[j].z * v[j].z + v[j].w * v[j].w); }
    const float r = rsqrtf(wave_sum(s) * (1.f / 4096.f) + EPS);
    v2u* o8 = (v2u*)orow + lane;
#pragma unroll
    for (int j = 0; j < 16; ++j) { const f32x4 g = gr[64 * j]; v2u o; o.x = pk2(v[j].x * r * g.x, v[j].y * r * g.y); o.y = pk2(v[j].z * r * g.z, v[j].w * r * g.w); o8[64 * j] = o; }
}
__device__ __forceinline__ void phase0(const Params& p, LAS unsigned char* lds, int tid, int wave, int lane) {
    LAS float* scr = (LAS float*)(lds + wave * 16640);
    const int gw = blockIdx.x * NWAVES + wave, NGW = gridDim.x * NWAVES;
    bf16* R = WSP(bf16, WS_R); unsigned char* R8 = WSP(unsigned char, WS_R8);
    constexpr int I_IN = 0, I_GT = 64 * 344, I_KV = 64 * 32, I_UR = 32 * 64, I_UA = 16 * 64, I_UM = 16 * 64, I_WO = 64 * 64, I_WQ = 64 * 32;
    constexpr int NITEMS = I_IN + I_GT + I_KV + I_UR + I_UA + I_UM + I_WO + I_WQ;
#ifndef SUBREP
#define SUBREP 0
#endif
    for (int it0 = gw; it0 < ((SUBREP & 32) ? 2 : 1) * NITEMS; it0 += NGW) {
        const int it = it0 >= NITEMS ? it0 - NITEMS : it0; int r = it;
        if (r < I_IN) { transpose_item(p.w_in, 6144, R, 4096, 8192, 0, 96, scr, r, lane, NPROJ); continue; } r -= I_IN;
        if (r < I_GT) { transpose_item_f8(p.w_in, NPROJ, 0, NPROJ, R8, 8704, 344, scr, r, lane); continue; } r -= I_GT;
        if (r < I_KV) { transpose_item_f8(p.w_mem_kv, 2048, 0, 2048, R8, 30720, 32, scr, r, lane); continue; } r -= I_KV;
        if (r < I_UR) { transpose_item(p.w_up_ret, 4096, WSP(bf16, WS_WUP), 4096, 0, 0, 64, scr, r, lane); continue; } r -= I_UR;
        if (r < I_UA) { transpose_item(p.w_up_att, 4096, WSP(bf16, WS_WUP), 4096, 0, 2048, 64, scr, r, lane); continue; } r -= I_UA;
        if (r < I_UM) { transpose_item(p.w_up_mem, 4096, WSP(bf16, WS_WUP), 4096, 0, 3072, 64, scr, r, lane); continue; } r -= I_UM;
        if (r < I_WO) { transpose_item(p.w_out, 4096, WSP(bf16, WS_WOUT), 4096, 0, 0, 64, scr, r, lane); continue; } r -= I_WO;
        transpose_item(p.peer_w_q, 2048, WSP(bf16, WS_WQ), 4096, 0, 0, 32, scr, r, lane, 0, p.ln2_g);
    }
    for (int m0 = gw; m0 < ((SUBREP & 64) ? 2 : 1) * NT; m0 += NGW) { const int m = m0 & (NT - 1); rms_row_to_both<false>(p.x + (size_t)m * DM, p.ln1_g, nullptr, R8 + (size_t)m * DM, lane); }
    for (int m = gw; m < NMEM; m += NGW) rms_row_to_both<false>(p.mem + (size_t)m * DM, p.mem_g, nullptr, R8 + (size_t)(NT + m) * DM, lane);
    {
        constexpr size_t NOCT = (size_t)16384 * 4096 / 8;
        const size_t stride = (size_t)gridDim.x * NTHR;
        for (size_t o0 = (size_t)blockIdx.x * NTHR + tid; o0 < (size_t)CONV_R0 * 512; o0 += 4 * stride) {
            f32x4 av[4], cv[4];
#pragma unroll
            for (int u = 0; u < 4; ++u) { size_t o = o0 + u * stride; o = o < (size_t)CONV_R0 * 512 ? o : o0; const bool isv = o >= NOCT; const size_t oo = isv ? o - NOCT : o;
                const float* __restrict__ src = (isv ? p.peer_v : p.peer_u) + oo * 8; av[u] = *(const f32x4*)src; cv[u] = *(const f32x4*)(src + 4); }
#pragma unroll
            for (int u = 0; u < 4; ++u) { const size_t o = o0 + u * stride; if (o >= (size_t)CONV_R0 * 512) break;
                const bool isv = o >= NOCT; const size_t oo = isv ? o - NOCT : o; unsigned char* dst = WSP(unsigned char, isv ? WS_V8 : WS_U8);
                f32x4 a = av[u], c = cv[u];
                if (!isv) { const float* g2 = p.ln2_g + (int)(oo & 511) * 8; a = a * *(const f32x4*)g2; c = c * *(const f32x4*)(g2 + 4); }
                float mx = fmaxf(fmaxf(fmaxf(fabsf(a.x), fabsf(a.y)), fmaxf(fabsf(a.z), fabsf(a.w))), fmaxf(fmaxf(fabsf(c.x), fabsf(c.y)), fmaxf(fabsf(c.z), fabsf(c.w))));
                mx = fmaxf(mx, __shfl_xor(mx, 1)); mx = fmaxf(mx, __shfl_xor(mx, 2));
                int ex = (int)ceilf(log2f(fmaxf(mx, 1e-30f) * (1.f / 6.f))); ex = ex < -120 ? -120 : (ex > 120 ? 120 : ex);
                const float inv = __uint_as_float((unsigned)(127 - ex) << 23);
                unsigned w = 0;
                w = __builtin_amdgcn_cvt_scalef32_pk_fp4_f32(w, a.x * inv, a.y * inv, 1.0f, 0); w = __builtin_amdgcn_cvt_scalef32_pk_fp4_f32(w, a.z * inv, a.w * inv, 1.0f, 1);
                w = __builtin_amdgcn_cvt_scalef32_pk_fp4_f32(w, c.x * inv, c.y * inv, 1.0f, 2); w = __builtin_amdgcn_cvt_scalef32_pk_fp4_f32(w, c.z * inv, c.w * inv, 1.0f, 3);
                const size_t row = oo >> 9; const int g8 = (int)(oo & 511);
                unsigned char* q = dst + (size_t)(g8 >> 6) * XSLICE + row * XSL;
                *(unsigned*)(q + 4 * (g8 & 63)) = w;
                if ((g8 & 3) == 0) q[256 + ((g8 & 63) >> 2)] = (unsigned char)(127 + ex);
            }
        }
    }
    bf16* skb = WSP(bf16, WS_SKB);
    for (int i = (blockIdx.x * NTHR + tid) * 4; i < 8 * 2 * 128 * 128; i += gridDim.x * NTHR * 4) { const f32x4 v = *(const f32x4*)(p.peer_sub_keys + i); v2u o; o.x = pk2(v.x, v.y); o.y = pk2(v.z, v.w); *(v2u*)(skb + i) = o; }
}

struct ConvRow { f32x4 a[8], c[8]; };
__device__ __forceinline__ void conv_row_load(const Params& p, int r, int lane, ConvRow& x) {
    const float* src0 = (r >= 16384 ? p.peer_v : p.peer_u) + (size_t)(r & 16383) * 4096;
#pragma unroll
    for (int u = 0; u < 8; ++u) { const float* src = src0 + (size_t)(64 * u + lane) * 8; x.a[u] = *(const f32x4*)src; x.c[u] = *(const f32x4*)(src + 4); }
}
__device__ __forceinline__ void conv_row_store(const Params& p, int r, int lane, const ConvRow& x) {
    const bool isv = r >= 16384; unsigned char* dst = WSP(unsigned char, isv ? WS_V8 : WS_U8); const int row = r & 16383;
#pragma unroll
    for (int u = 0; u < 8; ++u) {
        f32x4 a = x.a[u], c = x.c[u];
        if (!isv) { const float* g2 = p.ln2_g + (64 * u + lane) * 8; a = a * *(const f32x4*)g2; c = c * *(const f32x4*)(g2 + 4); }
        float mx = fmaxf(fmaxf(fmaxf(fabsf(a.x), fabsf(a.y)), fmaxf(fabsf(a.z), fabsf(a.w))), fmaxf(fmaxf(fabsf(c.x), fabsf(c.y)), fmaxf(fabsf(c.z), fabsf(c.w))));
        mx = fmaxf(mx, __shfl_xor(mx, 1)); mx = fmaxf(mx, __shfl_xor(mx, 2));
        int ex = (int)ceilf(log2f(fmaxf(mx, 1e-30f) * (1.f / 6.f))); ex = ex < -120 ? -120 : (ex > 120 ? 120 : ex);
        const float inv = __uint_as_float((unsigned)(127 - ex) << 23);
        unsigned w = 0;
        w = __builtin_amdgcn_cvt_scalef32_pk_fp4_f32(w, a.x * inv, a.y * inv, 1.0f, 0); w = __builtin_amdgcn_cvt_scalef32_pk_fp4_f32(w, a.z * inv, a.w * inv, 1.0f, 1);
        w = __builtin_amdgcn_cvt_scalef32_pk_fp4_f32(w, c.x * inv, c.y * inv, 1.0f, 2); w = __builtin_amdgcn_cvt_scalef32_pk_fp4_f32(w, c.z * inv, c.w * inv, 1.0f, 3);
        unsigned char* q = dst + (size_t)u * XSLICE + (size_t)row * XSL;
        *(unsigned*)(q + 4 * lane) = w;
        if ((lane & 3) == 0) q[256 + (lane >> 2)] = (unsigned char)(127 + ex);
    }
}
__device__ __forceinline__ void convert_rows_wave(const Params& p, int cw, int ncw, int lane) {
    const int nrows = 32768 - CONV_R0, per = (nrows / ncw) & ~1, beg = CONV_R0 + cw * per, end = (cw == ncw - 1) ? 32768 : beg + per;
    if (beg >= end) return;
    ConvRow A, B;
    conv_row_load(p, beg, lane, A);
#pragma unroll 1
    for (int r = beg; r < end; r += 2) {
        conv_row_load(p, r + 1, lane, B);
        conv_row_store(p, r, lane, A);
        if (r + 2 < end) conv_row_load(p, r + 2, lane, A);
        conv_row_store(p, r + 1, lane, B);
    }
}

__device__ __forceinline__ void unpack16(const bf16* src, float (&x)[16]) {
    const v4u a = *(const v4u*)src, b = *(const v4u*)(src + 8);
#pragma unroll
    for (int e = 0; e < 4; ++e) { x[2 * e] = bflo(a[e]); x[2 * e + 1] = bfhi(a[e]); x[8 + 2 * e] = bflo(b[e]); x[8 + 2 * e + 1] = bfhi(b[e]); }
}
__device__ __forceinline__ void pack16(bf16* dst, const float (&x)[16]) {
    v4u a, b;
#pragma unroll
    for (int e = 0; e < 4; ++e) { a[e] = pk2(x[2 * e], x[2 * e + 1]); b[e] = pk2(x[8 + 2 * e], x[8 + 2 * e + 1]); }
    *(v4u*)dst = a; *(v4u*)(dst + 8) = b;
}
__device__ __forceinline__ void norm_token(const Params& p, int bt, int lane) {
    const bf16* pr = WSP(const bf16, WS_PROJ) + (size_t)bt * LDP;
    { float x[16]; unpack16(pr + C_AQ + 16 * lane, x); float ss = 0.f;
#pragma unroll
      for (int i = 0; i < 16; ++i) ss += x[i] * x[i];
      ss += __shfl_xor(ss, 1); ss += __shfl_xor(ss, 2); ss += __shfl_xor(ss, 4);
      const float r = rsqrtf(ss * (1.f / 128.f) + EPS) * 0.08838834764831845f; const int d0 = (16 * lane) & 127;
#pragma unroll
      for (int i = 0; i < 16; ++i) x[i] *= r * p.att_q_g[d0 + i];
      pack16(WSP(bf16, WS_AQN) + (size_t)bt * 1024 + 16 * lane, x); }
    { const unsigned w = *(const unsigned*)(pr + C_AK + 2 * lane); const float x0 = bflo(w), x1 = bfhi(w);
      const float r = rsqrtf(wave_sum(x0 * x0 + x1 * x1) * (1.f / 128.f) + EPS);
      *(unsigned*)(WSP(bf16, WS_AKN) + (size_t)bt * 128 + 2 * lane) = pk2(x0 * r * p.att_k_g[2 * lane], x1 * r * p.att_k_g[2 * lane + 1]);
      *(unsigned*)(WSP(bf16, WS_AVC) + (size_t)bt * 128 + 2 * lane) = *(const unsigned*)(pr + C_AV + 2 * lane); }
    { float x[16]; unpack16(pr + C_MQ + 16 * lane, x); float ss = 0.f;
#pragma unroll
      for (int i = 0; i < 16; ++i) ss += x[i] * x[i];
      ss += __shfl_xor(ss, 1); ss += __shfl_xor(ss, 2); ss += __shfl_xor(ss, 4); ss += __shfl_xor(ss, 8);
      const float r = rsqrtf(ss * (1.f / 256.f) + EPS) * 0.0625f; const int d0 = (16 * lane) & 255;
#pragma unroll
      for (int i = 0; i < 16; ++i) x[i] *= r * p.mem_q_g[d0 + i];
      pack16(WSP(bf16, WS_MQN) + (size_t)bt * 1024 + 16 * lane, x); }
}
__device__ __forceinline__ void unpack16v(const v4u a, const v4u b, float (&x)[16]) {
#pragma unroll
    for (int e = 0; e < 4; ++e) { x[2 * e] = bflo(a[e]); x[2 * e + 1] = bfhi(a[e]); x[8 + 2 * e] = bflo(b[e]); x[8 + 2 * e + 1] = bfhi(b[e]); }
}
__device__ __forceinline__ void norm_tokens4(const Params& p, int bt0, int stride, int lane) {
    const bf16* __restrict__ proj = WSP(const bf16, WS_PROJ);
    v4u aq[4][2], mq[4][2]; unsigned ak[4], av[4];
#pragma unroll
    for (int u = 0; u < 4; ++u) { const int bt = (bt0 + u * stride) < NT ? (bt0 + u * stride) : bt0; const bf16* pr = proj + (size_t)bt * LDP;
        aq[u][0] = *(const v4u*)(pr + C_AQ + 16 * lane); aq[u][1] = *(const v4u*)(pr + C_AQ + 16 * lane + 8);
        ak[u] = *(const unsigned*)(pr + C_AK + 2 * lane); av[u] = *(const unsigned*)(pr + C_AV + 2 * lane);
        mq[u][0] = *(const v4u*)(pr + C_MQ + 16 * lane); mq[u][1] = *(const v4u*)(pr + C_MQ + 16 * lane + 8); }
    float gq[16], gm[16];
    { const int dq = (16 * lane) & 127, dm = (16 * lane) & 255;
#pragma unroll
      for (int i = 0; i < 4; ++i) { const f32x4 a = *(const f32x4*)(p.att_q_g + dq + 4 * i), b = *(const f32x4*)(p.mem_q_g + dm + 4 * i);
          gq[4 * i] = a.x; gq[4 * i + 1] = a.y; gq[4 * i + 2] = a.z; gq[4 * i + 3] = a.w; gm[4 * i] = b.x; gm[4 * i + 1] = b.y; gm[4 * i + 2] = b.z; gm[4 * i + 3] = b.w; } }
    const float gk0 = p.att_k_g[2 * lane], gk1 = p.att_k_g[2 * lane + 1];
#pragma unroll
    for (int u = 0; u < 4; ++u) { const int bt = bt0 + u * stride; if (bt >= NT) break;
        { float x[16]; unpack16v(aq[u][0], aq[u][1], x); float ss = 0.f;
#pragma unroll
          for (int i = 0; i < 16; ++i) ss += x[i] * x[i];
          ss += __shfl_xor(ss, 1); ss += __shfl_xor(ss, 2); ss += __shfl_xor(ss, 4);
          const float r = rsqrtf(ss * (1.f / 128.f) + EPS) * 0.08838834764831845f;
#pragma unroll
          for (int i = 0; i < 16; ++i) x[i] *= r * gq[i];
          pack16(WSP(bf16, WS_AQN) + (size_t)bt * 1024 + 16 * lane, x); }
        { const float x0 = bflo(ak[u]), x1 = bfhi(ak[u]);
          const float r = rsqrtf(wave_sum(x0 * x0 + x1 * x1) * (1.f / 128.f) + EPS);
          *(unsigned*)(WSP(bf16, WS_AKN) + (size_t)bt * 128 + 2 * lane) = pk2(x0 * r * gk0, x1 * r * gk1);
          *(unsigned*)(WSP(bf16, WS_AVC) + (size_t)bt * 128 + 2 * lane) = av[u]; }
        { float x[16]; unpack16v(mq[u][0], mq[u][1], x); float ss = 0.f;
#pragma unroll
          for (int i = 0; i < 16; ++i) ss += x[i] * x[i];
          ss += __shfl_xor(ss, 1); ss += __shfl_xor(ss, 2); ss += __shfl_xor(ss, 4); ss += __shfl_xor(ss, 8);
          const float r = rsqrtf(ss * (1.f / 256.f) + EPS) * 0.0625f;
#pragma unroll
          for (int i = 0; i < 16; ++i) x[i] *= r * gm[i];
          pack16(WSP(bf16, WS_MQN) + (size_t)bt * 1024 + 16 * lane, x); }
    }
}
__device__ __forceinline__ void norm_memtoken(const Params& p, int m, int lane) {
    float x[16]; unpack16(WSP(const bf16, WS_MK) + (size_t)m * 1024 + 16 * lane, x); float ss = 0.f;
#pragma unroll
    for (int i = 0; i < 16; ++i) ss += x[i] * x[i];
    ss += __shfl_xor(ss, 1); ss += __shfl_xor(ss, 2); ss += __shfl_xor(ss, 4); ss += __shfl_xor(ss, 8);
    const float r = rsqrtf(ss * (1.f / 256.f) + EPS); const int d0 = (16 * lane) & 255;
#pragma unroll
    for (int i = 0; i < 16; ++i) x[i] *= r * p.mem_k_g[d0 + i];
    pack16(WSP(bf16, WS_MKN) + (size_t)m * 1024 + 16 * lane, x);
}
__device__ __forceinline__ void stage_rot(const bf16* __restrict__ src, int bt0, const int* __restrict__ pos, LAS unsigned char* dst, float lg, int mode, int tid) {
    v4u av[2], bv[2]; int pi[2];
#pragma unroll
    for (int it = 0; it < 2; ++it) { const int task = tid + it * NTHR, j = task >> 3, pc = task & 7; const bf16* rp = src + (size_t)(bt0 + j) * LDP + 8 * pc;
        av[it] = *(const v4u*)rp; bv[it] = *(const v4u*)(rp + 64); pi[it] = pos[bt0 + j]; }
#pragma unroll
    for (int it = 0; it < 2; ++it) {
        const int task = tid + it * NTHR, j = task >> 3, pc = task & 7;
        const v4u a = av[it], b = bv[it];
        const float ps = (float)pi[it];
        float sc = 1.f; if (mode >= 1) sc = 0.08838834764831845f; if (mode == 2) sc *= exp2f((float)(127 - j) * lg);
        float o1[8], o2[8];
#pragma unroll
        for (int e = 0; e < 8; ++e) {
            const float x1 = (e & 1) ? bfhi(a[e >> 1]) : bflo(a[e >> 1]), x2 = (e & 1) ? bfhi(b[e >> 1]) : bflo(b[e >> 1]);
            const float invf = exp2f(-(float)(8 * pc + e) * (13.287712379549449f / 64.f));
            float rev = ps * invf * 0.15915494309189535f; rev -= floorf(rev);
            const float sn = __builtin_amdgcn_sinf(rev), cs = __builtin_amdgcn_cosf(rev);
            o1[e] = (x1 * cs - x2 * sn) * sc; o2[e] = (x1 * sn + x2 * cs) * sc; }
        v4u w1, w2;
#pragma unroll
        for (int e = 0; e < 4; ++e) { w1[e] = pk2(o1[2 * e], o1[2 * e + 1]); w2[e] = pk2(o2[2 * e], o2[2 * e + 1]); }
        *(LAS v4u*)(dst + j * 288 + 16 * pc) = w1; *(LAS v4u*)(dst + j * 288 + 128 + 16 * pc) = w2;
    }
}
struct Tile256 { v4u t[8]; };
__device__ __forceinline__ void stage_256_load(const bf16* __restrict__ src, size_t ld, int tid, Tile256& r) {
#pragma unroll
    for (int i = 0; i < 8; ++i) { const int task = tid + i * NTHR, j = task >> 5, ch = task & 31; r.t[i] = *(const v4u*)(src + (size_t)j * ld + 8 * ch); }
}
__device__ __forceinline__ void stage_256_store(LAS unsigned char* dst, int tid, const Tile256& r) {
#pragma unroll
    for (int i = 0; i < 8; ++i) { const int task = tid + i * NTHR, j = task >> 5, ch = task & 31; *(LAS v4u*)(dst + j * 544 + 16 * ch) = r.t[i]; }
}
__device__ __forceinline__ float log2_gamma(int h) { return log2f(1.f - exp2f(-5.f - (float)h)); }
__device__ __forceinline__ void r1_item(const Params& p, LAS unsigned char* lds, int item, int tid, int wave, int lane) {
    const int bh = item >> 5, c = item & 31, b = bh >> 3, h = bh & 7, bt0 = b * SEQ + c * 128;
    const float lg = log2_gamma(h);
    const bf16* proj = WSP(const bf16, WS_PROJ);
    LAS unsigned char* Kl = lds; LAS unsigned char* Vl = lds + 36864;
    { Tile256 vt; stage_256_load(proj + (size_t)bt0 * LDP + C_RV + h * 256, LDP, tid, vt); stage_256_store(Vl, tid, vt); }
    stage_rot(proj + C_RK + h * 128, bt0, p.pos, Kl, lg, 2, tid);
    __syncthreads();
    const int g = lane >> 4, n = lane & 15, q4 = n >> 2, pp = lane & 3;
    f32x4 acc[16];
#pragma unroll
    for (int nt = 0; nt < 16; ++nt) acc[nt] = (f32x4){0.f, 0.f, 0.f, 0.f};
#pragma unroll
    for (int ks = 0; ks < 4; ++ks) {
        const int row0 = 32 * ks + 8 * g + q4;
        const unsigned ka = lds_addr(Kl) + row0 * 288 + (16 * wave + 4 * pp) * 2;
        const bf16x8 kf = tr_read8(ka, ka + 4 * 288);
        const unsigned va = lds_addr(Vl) + row0 * 544 + (4 * pp) * 2;
#pragma unroll
        for (int nb = 0; nb < 4; ++nb) { bf16x8 vf[4]; tr_read8x4(va + 128 * nb, va + 128 * nb + 4 * 544, vf);
#pragma unroll
            for (int q = 0; q < 4; ++q) acc[4 * nb + q] = mfma16(vf[q], kf, acc[4 * nb + q]); }
    }
    float* o = WSP(float, WS_SC) + (size_t)item * 32768 + (16 * wave + n) * 256 + 4 * g;
#pragma unroll
    for (int nt = 0; nt < 16; ++nt) *(f32x4*)(o + 16 * nt) = acc[nt];
    __syncthreads();
}
__device__ __forceinline__ void a1_item(const Params& p, LAS unsigned char* lds, int item, int tid, int wave, int lane) {
    const int b = item >> 8, qt = item & 255, bt0 = b * SEQ + 16 * qt;
    const bf16* proj = WSP(const bf16, WS_PROJ);
    {   v4u qv[4];
#pragma unroll
        for (int it = 0; it < 4; ++it) { const int task = tid + it * NTHR, q = task >> 7, ch = task & 127; qv[it] = *(const v4u*)(proj + (size_t)(bt0 + q) * LDP + C_IQ + 8 * ch); }
#pragma unroll
        for (int it = 0; it < 4; ++it) { const int task = tid + it * NTHR, q = task >> 7, ch = task & 127, h = ch >> 3, c8 = ch & 7; *(LAS v4u*)(lds + (h * 16 + q) * 144 + 16 * c8) = qv[it]; } }
    const int g = lane >> 4, n = lane & 15;
    LAS float* wl = (LAS float*)(lds + 36864);
    if (tid < 256) { const unsigned short wv = *(proj + (size_t)(bt0 + (tid >> 4)) * LDP + C_IW + (tid & 15)); wl[tid] = __uint_as_float(((unsigned)wv) << 16) * 0.03125f; }
    __syncthreads();
    float* scores = WSP(float, WS_SCORES);
    bf16x8 na0, na1;
    { const int kt0 = wave <= qt ? wave : 0; const bf16* kp = proj + (size_t)(b * SEQ + 16 * kt0 + n) * LDP + C_IK + 8 * g; na0 = *(const bf16x8*)kp; na1 = *(const bf16x8*)(kp + 32); }
    for (int kt = wave; kt <= qt; kt += NWAVES) {
        const bf16x8 a0 = na0, a1 = na1;
        { const int ktn = kt + NWAVES <= qt ? kt + NWAVES : kt; const bf16* kp = proj + (size_t)(b * SEQ + 16 * ktn + n) * LDP + C_IK + 8 * g; na0 = *(const bf16x8*)kp; na1 = *(const bf16x8*)(kp + 32); }
        f32x4 sc = (f32x4){0.f, 0.f, 0.f, 0.f};
#pragma unroll 4
        for (int h = 0; h < 16; ++h) {
            const bf16x8 b0 = *(const LAS bf16x8*)(lds + (h * 16 + n) * 144 + 16 * g), b1 = *(const LAS bf16x8*)(lds + (h * 16 + n) * 144 + 64 + 16 * g);
            const float wh = wl[n * 16 + h];
            f32x4 cc = mfma16(a0, b0, (f32x4){0.f, 0.f, 0.f, 0.f}); cc = mfma16(a1, b1, cc);
#pragma unroll
            for (int r = 0; r < 4; ++r) sc[r] += wh * fmaxf(cc[r], 0.f);
        }
        *(f32x4*)(scores + (size_t)(bt0 + n) * SEQ + 16 * kt + 4 * g) = sc;
    }
    __syncthreads();
}
__device__ __forceinline__ void phase2a(const Params& p, LAS unsigned char* lds, int tid, int wave, int lane) {
    const int gw = blockIdx.x * NWAVES + wave, NGW = gridDim.x * NWAVES;
    for (int bt = gw; bt < NT; bt += 4 * NGW) norm_tokens4(p, bt, NGW, lane);
    for (int m = gw; m < NMEM; m += NGW) norm_memtoken(p, m, lane);
#ifndef SUBREP
#define SUBREP 0
#endif
    for (int rep = 0; rep < ((SUBREP & 8) ? 2 : 1); ++rep)
    for (int it = blockIdx.x; it < 512; it += gridDim.x) r1_item(p, lds, it, tid, wave, lane);
    for (int rep = 0; rep < ((SUBREP & 16) ? 2 : 1); ++rep)
    for (int it = blockIdx.x; it < 256; it += gridDim.x) { a1_item(p, lds, it, tid, wave, lane); a1_item(p, lds, 511 - it, tid, wave, lane); }
}

__device__ __forceinline__ unsigned okey(float v) { const unsigned u = __float_as_uint(v); return (u & 0x80000000u) ? ~u : (u | 0x80000000u); }
template <int NJ>
__device__ __forceinline__ void a2_row(const Params& p, LAS unsigned* hist, int bt, int lane) {
    const int t = bt & (SEQ - 1), n = t + 1;
    unsigned short* out = WSP(unsigned short, WS_IDX) + (size_t)bt * 256;
    if (n <= 256) { for (int s = lane; s < n; s += 64) out[s] = (unsigned short)s; return; }
    const float* row = WSP(const float, WS_SCORES) + (size_t)bt * SEQ;
    unsigned key[NJ];
#pragma unroll
    for (int j = 0; j < NJ; ++j) { const int s = 64 * j + lane; key[j] = __float_as_uint(row[s < n ? s : n - 1]); }
#pragma unroll
    for (int j = 0; j < NJ; ++j) { const int s = 64 * j + lane; key[j] = s < n ? okey(__uint_as_float(key[j])) : 0u; }
    unsigned kmax = 0u, kmin = 0xffffffffu;
#pragma unroll
    for (int j = 0; j < NJ; ++j) { kmax = max(kmax, key[j]); kmin = min(kmin, key[j] ? key[j] : 0xffffffffu); }
#pragma unroll
    for (int o = 1; o < 64; o <<= 1) { kmax = max(kmax, (unsigned)__shfl_xor((int)kmax, o)); kmin = min(kmin, (unsigned)__shfl_xor((int)kmin, o)); }
    kmax = (unsigned)__builtin_amdgcn_readfirstlane((int)kmax); kmin = (unsigned)__builtin_amdgcn_readfirstlane((int)kmin);
    unsigned T = kmax; int need = 256;
    const unsigned diff = kmax ^ kmin;
    if (diff != 0u) {
        int hi = 31 - __builtin_clz(diff);
        T = (hi == 31) ? 0u : (kmax >> (hi + 1)) << (hi + 1);
        while (hi >= 0) {
            const int lo = hi >= 7 ? hi - 7 : 0; const unsigned dmask = (1u << (hi - lo + 1)) - 1u;
            *(LAS v4u*)(hist + 4 * lane) = (v4u){0u, 0u, 0u, 0u};
            LDS_WAIT(); asm volatile("" ::: "memory");
#pragma unroll
            for (int j = 0; j < NJ; ++j) { const bool m = (hi == 31) ? (key[j] != 0u) : ((((key[j] ^ T) >> (hi + 1)) == 0u) && key[j] != 0u);
                if (m) __hip_atomic_fetch_add(hist + ((key[j] >> lo) & dmask), 1u, __ATOMIC_RELAXED, __HIP_MEMORY_SCOPE_WORKGROUP); }
            LDS_WAIT(); asm volatile("" ::: "memory");
            const v4u h4 = *(const LAS v4u*)(hist + 4 * lane);
            const int tot = (int)(h4.x + h4.y + h4.z + h4.w);
            int incl = tot;
#pragma unroll
            for (int o = 1; o < 64; o <<= 1) { const int v = __shfl_up(incl, o); if (lane >= o) incl += v; }
            const int total = __builtin_amdgcn_readlane(incl, 63);
            const int above_l = total - incl;
            const bool here = (above_l < need) && (need <= above_l + tot);
            const int c3 = above_l + (int)h4.w, c2 = c3 + (int)h4.z, c1 = c2 + (int)h4.y;
            int d_l, ab_l, cn_l;
            if (c3 >= need) { d_l = 4 * lane + 3; ab_l = above_l; cn_l = (int)h4.w; } else if (c2 >= need) { d_l = 4 * lane + 2; ab_l = c3; cn_l = (int)h4.z; }
            else if (c1 >= need) { d_l = 4 * lane + 1; ab_l = c2; cn_l = (int)h4.y; } else { d_l = 4 * lane; ab_l = c1; cn_l = (int)h4.x; }
            const unsigned long long hm = __ballot(here);
            const int src = hm ? (int)__builtin_ctzll(hm) : 0;
            const int d = __builtin_amdgcn_readlane(d_l, src), ab = __builtin_amdgcn_readlane(ab_l, src), cn = __builtin_amdgcn_readlane(cn_l, src);
            T |= (unsigned)d << lo; need -= ab;
            if (cn == need) break;
            hi = lo - 1;
        }
    }
    const unsigned long long lt = (1ull << lane) - 1ull;
    LAS unsigned short* lst = (LAS unsigned short*)hist;
    int posn = 0;
#pragma unroll
    for (int j = 0; j < NJ; ++j) { const bool pred = key[j] > T; const unsigned long long mask = __ballot(pred); const int off = posn + __popcll(mask & lt);
        if (pred) lst[off] = (unsigned short)(64 * j + lane); posn += __popcll(mask); }
#pragma unroll
    for (int j = 0; j < NJ; ++j) { const bool pred = key[j] == T; const unsigned long long mask = __ballot(pred); const int off = posn + __popcll(mask & lt);
        if (pred && off < 256) lst[off] = (unsigned short)(64 * j + lane); posn += __popcll(mask); }
    LDS_WAIT(); asm volatile("" ::: "memory");
    *(v2u*)(out + 4 * lane) = *(const LAS v2u*)(lst + 4 * lane);
    LDS_WAIT(); asm volatile("" ::: "memory");
}
__device__ __forceinline__ void phase2b(const Params& p, LAS unsigned char* lds, int tid, int wave, int lane) {
    const float* Sc = WSP(const float, WS_SC); bf16* ST = WSP(bf16, WS_ST);
    for (int id0 = blockIdx.x * NTHR + tid; id0 < ((SUBREP & 1024) ? 2 : 1) * 16 * 8192; id0 += gridDim.x * NTHR) {
        const int id = id0 & (16 * 8192 - 1); const int bh = id >> 13, e4 = id & 8191; const float cd = exp2f(128.f * log2_gamma(bh & 7));
        f32x4 st = (f32x4){0.f, 0.f, 0.f, 0.f};
        const float* __restrict__ sp = Sc + (size_t)(bh * 32) * 32768 + 4 * e4; bf16* __restrict__ op = ST + (size_t)(bh * 32) * 32768 + 4 * e4;
#pragma unroll 1
        for (int c0 = 0; c0 < 32; c0 += 8) {
            f32x4 s[8];
#pragma unroll
            for (int j = 0; j < 8; ++j) s[j] = *(const f32x4*)(sp + (size_t)(c0 + j) * 32768);
#pragma unroll
            for (int j = 0; j < 8; ++j) { v2u o; o.x = pk2(st.x, st.y); o.y = pk2(st.z, st.w); *(v2u*)(op + (size_t)(c0 + j) * 32768) = o; st = st * cd + s[j]; }
        }
    }
    const int gw = blockIdx.x * NWAVES + wave, NGW = gridDim.x * NWAVES;
#pragma unroll 1
    for (int i = gw; i < NT; i += NGW) {
        const int u = i & (SEQ - 1), t = u < SEQ / 2 ? u : (SEQ + SEQ / 2 - 1) - u, bt = (i & ~(SEQ - 1)) | t;
        LAS unsigned* hist = (LAS unsigned*)(lds + wave * 1024);
        if (t < 1024) a2_row<16>(p, hist, bt, lane); else if (t < 2048) a2_row<32>(p, hist, bt, lane);
        else if (t < 3072) a2_row<48>(p, hist, bt, lane); else a2_row<64>(p, hist, bt, lane);
    }
}

__device__ __forceinline__ v2u pack4(float a, float b, float c, float d) { v2u o; o.x = pk2(a, b); o.y = pk2(c, d); return o; }
__device__ __forceinline__ void r3_item(const Params& p, LAS unsigned char* lds, int item, int tid, int wave, int lane) {
    const int bh = item >> 5, c = item & 31, b = bh >> 3, h = bh & 7, bt0 = b * SEQ + c * 128;
    const float lg = log2_gamma(h);
    const bf16* proj = WSP(const bf16, WS_PROJ);
    LAS unsigned char* Ql = lds; LAS unsigned char* Kl = lds + 36864; LAS unsigned char* Vl = lds + 73728;
    {   Tile256 st; stage_256_load(WSP(const bf16, WS_ST) + (size_t)item * 32768, 256, tid, st);
        stage_rot(proj + C_RQ + h * 128, bt0, p.pos, Ql, lg, 0, tid);
        stage_rot(proj + C_RK + h * 128, bt0, p.pos, Kl, lg, 1, tid);
        stage_256_store(Vl, tid, st); }
    __syncthreads();
    const int g = lane >> 4, n = lane & 15, q4 = n >> 2, pp = lane & 3;
    const int i = 16 * wave + n;
    f32x4 sacc[8];
#pragma unroll
    for (int jt = 0; jt < 8; ++jt) sacc[jt] = (f32x4){0.f, 0.f, 0.f, 0.f};
    f32x4 oacc[16];
#pragma unroll
    for (int nt = 0; nt < 16; ++nt) oacc[nt] = (f32x4){0.f, 0.f, 0.f, 0.f};
#pragma unroll 1
    for (int ks = 0; ks < 4; ++ks) {
        const bf16x8 qf = *(const LAS bf16x8*)(Ql + i * 288 + 64 * ks + 16 * g);
#pragma unroll
        for (int jt = 0; jt < 8; ++jt) { const bf16x8 kf = *(const LAS bf16x8*)(Kl + (16 * jt + n) * 288 + 64 * ks + 16 * g); sacc[jt] = mfma16(kf, qf, sacc[jt]); }
        const unsigned sa = lds_addr(Vl) + (32 * ks + 8 * g + q4) * 544 + (4 * pp) * 2;
#pragma unroll
        for (int nb = 0; nb < 4; ++nb) { bf16x8 sf[4]; tr_read8x4(sa + 128 * nb, sa + 128 * nb + 4 * 544, sf);
#pragma unroll
            for (int q = 0; q < 4; ++q) oacc[4 * nb + q] = mfma16(sf[q], qf, oacc[4 * nb + q]); }
    }
    const float qd = exp2f((float)(i + 1) * lg);
#pragma unroll
    for (int nt = 0; nt < 16; ++nt) oacc[nt] = oacc[nt] * qd;
    __syncthreads();
#pragma unroll
    for (int jt = 0; jt < 8; ++jt) { float pv[4];
#pragma unroll
        for (int r = 0; r < 4; ++r) { const int j = 16 * jt + 4 * g + r; pv[r] = (i >= j) ? sacc[jt][r] * exp2f((float)(i - j) * lg) : 0.f; }
        *(LAS v2u*)(Kl + i * 288 + (16 * jt + 4 * g) * 2) = pack4(pv[0], pv[1], pv[2], pv[3]); }
    { Tile256 vt; stage_256_load(proj + (size_t)bt0 * LDP + C_RV + h * 256, LDP, tid, vt); stage_256_store(Vl, tid, vt); }
    __syncthreads();
#pragma unroll 1
    for (int ks = 0; ks < 4; ++ks) {
        const bf16x8 pf = *(const LAS bf16x8*)(Kl + i * 288 + 64 * ks + 16 * g);
        const unsigned va = lds_addr(Vl) + (32 * ks + 8 * g + q4) * 544 + (4 * pp) * 2;
#pragma unroll
        for (int nb = 0; nb < 4; ++nb) { bf16x8 vf[4]; tr_read8x4(va + 128 * nb, va + 128 * nb + 4 * 544, vf);
#pragma unroll
            for (int q = 0; q < 4; ++q) oacc[4 * nb + q] = mfma16(vf[q], pf, oacc[4 * nb + q]); }
    }
    float ss = 0.f;
#pragma unroll
    for (int nt = 0; nt < 16; ++nt)
#pragma unroll
        for (int r = 0; r < 4; ++r) ss += oacc[nt][r] * oacc[nt][r];
    ss += __shfl_xor(ss, 16); ss += __shfl_xor(ss, 32);
    const float rn = rsqrtf(ss * (1.f / 256.f) + EPS);
    const bf16* __restrict__ gp = proj + (size_t)(bt0 + i) * LDP + C_RG + h * 256 + 4 * g; bf16* __restrict__ yp = WSP(bf16, WS_Y) + (size_t)(bt0 + i) * DM + h * 256 + 4 * g;
#pragma unroll
    for (int nt = 0; nt < 16; ++nt) { const v2u gw = *(const v2u*)(gp + 16 * nt); float gt[4] = {bflo(gw.x), bfhi(gw.x), bflo(gw.y), bfhi(gw.y)}; float y[4];
#pragma unroll
        for (int r = 0; r < 4; ++r) y[r] = gt[r] / (1.f + __expf(-gt[r])) * oacc[nt][r] * rn;
        *(v2u*)(yp + 16 * nt) = pack4(y[0], y[1], y[2], y[3]); }
    __syncthreads();
}
__device__ __forceinline__ int t5_bucket(int n) {
    if (n < 16) return n;
    const int l = 16 + (int)(logf((float)n * 0.0625f) / 2.0794415416798357f * 16.f);
    return l < 31 ? l : 31;
}
constexpr int A3_VROW = 272, A3_VBYTES = 64 * A3_VROW, A3_TAB = 8 * A3_VBYTES, A3_IDX = A3_TAB + 4096 + 1024;
static_assert(A3_IDX + 8 * 512 <= LDS_SCR, "A3 LDS map");
__device__ __forceinline__ void a3_tables(const Params& p, LAS unsigned char* lds, int tid) {
    for (int d = tid; d < 4096; d += NTHR) lds[A3_TAB + d] = (unsigned char)t5_bucket(d);
    if (tid < 256) ((LAS float*)(lds + A3_TAB + 4096))[tid] = p.rel_bias[tid];
    __syncthreads();
}
struct A3In { v2u iv; bf16x8 qf[4]; };
__device__ __forceinline__ void a3_fetch(const Params& p, int bt, int lane, A3In& in) {
    const int g = lane >> 4, n = lane & 15;
    in.iv = *(const v2u*)(WSP(const unsigned short, WS_IDX) + (size_t)bt * 256 + 4 * lane);
#pragma unroll
    for (int ks = 0; ks < 4; ++ks) { in.qf[ks] = (bf16x8){0, 0, 0, 0, 0, 0, 0, 0}; if (n < 8) in.qf[ks] = *(const bf16x8*)(WSP(const bf16, WS_AQN) + (size_t)bt * 1024 + n * 128 + 32 * ks + 8 * g); }
}
__device__ __forceinline__ void a3_query(const Params& p, LAS unsigned char* lds, int bt, int wave, int lane, const A3In& in) {
    const int b = bt >> 12, t = bt & (SEQ - 1), cnt = (t + 1 < 256) ? (t + 1) : 256;
    const int g = lane >> 4, n = lane & 15, q4 = n >> 2, pp = lane & 3;
    const bf16* akn = WSP(const bf16, WS_AKN) + (size_t)b * SEQ * 128; const bf16* avc = WSP(const bf16, WS_AVC) + (size_t)b * SEQ * 128;
    LAS unsigned char* Vl = lds + wave * A3_VBYTES;
    const LAS unsigned char* bkt = lds + A3_TAB; const LAS float* rbl = (const LAS float*)(lds + A3_TAB + 4096);
    LAS unsigned short* il = (LAS unsigned short*)(lds + A3_IDX + wave * 512);
    {
        v2u iv = in.iv;
        if (4 * lane + 0 >= cnt) iv.x &= 0xffff0000u; if (4 * lane + 1 >= cnt) iv.x &= 0x0000ffffu; if (4 * lane + 2 >= cnt) iv.y &= 0xffff0000u; if (4 * lane + 3 >= cnt) iv.y &= 0x0000ffffu;
        *(LAS v2u*)(il + 4 * lane) = iv;
    }
    bf16x8 qf[4];
#pragma unroll
    for (int ks = 0; ks < 4; ++ks) qf[ks] = in.qf[ks];
    LDS_WAIT(); asm volatile("" ::: "memory");
    float pr[16][4];
#pragma unroll
    for (int kb = 0; kb < 4; ++kb) {
        bf16x8 kf[4][4];
#pragma unroll
        for (int j = 0; j < 4; ++j) { const bf16* kp = akn + (size_t)il[16 * (4 * kb + j) + n] * 128 + 8 * g;
#pragma unroll
            for (int ks = 0; ks < 4; ++ks) kf[j][ks] = *(const bf16x8*)(kp + 32 * ks); }
#pragma unroll
        for (int j = 0; j < 4; ++j) { const int kt = 4 * kb + j;
            f32x4 cc = (f32x4){0.f, 0.f, 0.f, 0.f};
#pragma unroll
            for (int ks = 0; ks < 4; ++ks) cc = mfma16(kf[j][ks], qf[ks], cc);
            const v2u i4 = *(const LAS v2u*)(il + 16 * kt + 4 * g);
            const int k4[4] = {(int)(i4.x & 0xffffu), (int)(i4.x >> 16), (int)(i4.y & 0xffffu), (int)(i4.y >> 16)};
#pragma unroll
            for (int r = 0; r < 4; ++r) { const bool valid = (16 * kt + 4 * g + r) < cnt; const int dist = valid ? t - k4[r] : 0;
                pr[kt][r] = valid ? cc[r] + rbl[(int)bkt[dist & 4095] * 8 + (n & 7)] : -INFINITY; } }
    }
    float m = pr[0][0];
#pragma unroll
    for (int kt = 0; kt < 16; ++kt)
#pragma unroll
        for (int r = 0; r < 4; ++r) m = fmaxf(m, pr[kt][r]);
    m = fmaxf(m, __shfl_xor(m, 16)); m = fmaxf(m, __shfl_xor(m, 32));
    float s = 0.f;
#pragma unroll
    for (int kt = 0; kt < 16; ++kt)
#pragma unroll
        for (int r = 0; r < 4; ++r) { const float e = exp2f((pr[kt][r] - m) * 1.4426950408889634f); pr[kt][r] = e; s += e; }
    s += __shfl_xor(s, 16); s += __shfl_xor(s, 32);
    const float inv = 1.f / s;
    f32x4 acc[8];
#pragma unroll
    for (int dt = 0; dt < 8; ++dt) acc[dt] = (f32x4){0.f, 0.f, 0.f, 0.f};
    v4u vv[16];
#pragma unroll
    for (int i = 0; i < 16; ++i) vv[i] = *(const v4u*)(avc + (size_t)il[g + 4 * i] * 128 + 8 * n);
#pragma unroll
    for (int ch = 0; ch < 4; ++ch) {
        if (64 * ch < cnt) {
#pragma unroll
            for (int i = 0; i < 16; ++i) *(LAS v4u*)(Vl + (g + 4 * i) * A3_VROW + 16 * n) = vv[i];
            if (ch < 3 && 64 * (ch + 1) < cnt) {
#pragma unroll
                for (int i = 0; i < 16; ++i) vv[i] = *(const v4u*)(avc + (size_t)il[64 * (ch + 1) + g + 4 * i] * 128 + 8 * n);
            }
            LDS_WAIT(); asm volatile("" ::: "memory");
#pragma unroll
            for (int s2 = 0; s2 < 2; ++s2) {
                const int jt0 = 4 * ch + 2 * s2;
                bf16x8 pb; { const v2u lo = pack4(pr[jt0][0] * inv, pr[jt0][1] * inv, pr[jt0][2] * inv, pr[jt0][3] * inv), hi = pack4(pr[jt0 + 1][0] * inv, pr[jt0 + 1][1] * inv, pr[jt0 + 1][2] * inv, pr[jt0 + 1][3] * inv);
                    union { v4u u; bf16x8 h; } cv; cv.u = (v4u){lo.x, lo.y, hi.x, hi.y}; pb = cv.h; }
                const unsigned a0 = lds_addr(Vl) + (32 * s2 + 4 * g + q4) * A3_VROW + 8 * pp, a1 = a0 + 16 * A3_VROW;
                bf16x8 vf[4];
                tr_read8x4(a0, a1, vf);
#pragma unroll
                for (int j = 0; j < 4; ++j) acc[j] = mfma16(vf[j], pb, acc[j]);
                tr_read8x4(a0 + 128, a1 + 128, vf);
#pragma unroll
                for (int j = 0; j < 4; ++j) acc[4 + j] = mfma16(vf[j], pb, acc[4 + j]);
            }
        }
    }
    if (n < 8) { bf16* yp = WSP(bf16, WS_Y) + (size_t)bt * DM + 2048 + n * 128 + 4 * g;
#pragma unroll
        for (int dt = 0; dt < 8; ++dt) *(v2u*)(yp + 16 * dt) = pack4(acc[dt][0], acc[dt][1], acc[dt][2], acc[dt][3]); }
}
__device__ __forceinline__ void m_item(const Params& p, LAS unsigned char* lds, int item, int tid, int wave, int lane) {
    const int b = item >> 7, head = (item >> 5) & 3, qb = item & 31, bt0 = b * SEQ + 128 * qb;
    LAS unsigned char* R1 = lds; LAS unsigned char* R2 = lds + 73728;
    const bf16* mkn = WSP(const bf16, WS_MKN); const bf16* mqn = WSP(const bf16, WS_MQN); const bf16* mvT = WSP(const bf16, WS_MVT);
    const int g = lane >> 4, n = lane & 15, i = 16 * wave + n;
    f32x4 sacc[16];
#pragma unroll
    for (int mt = 0; mt < 16; ++mt) sacc[mt] = (f32x4){0.f, 0.f, 0.f, 0.f};
    for (int hh = 0; hh < 2; ++hh) {
        if (hh) __syncthreads();
        {   v4u kv[8], qv[4];
#pragma unroll
            for (int it = 0; it < 8; ++it) { const int task = tid + it * NTHR, m = task >> 4, ch = task & 15; kv[it] = *(const v4u*)(mkn + (size_t)(b * MEML + m) * 1024 + head * 256 + 128 * hh + 8 * ch); }
#pragma unroll
            for (int it = 0; it < 4; ++it) { const int task = tid + it * NTHR, q = task >> 4, ch = task & 15; qv[it] = *(const v4u*)(mqn + (size_t)(bt0 + q) * 1024 + head * 256 + 128 * hh + 8 * ch); }
#pragma unroll
            for (int it = 0; it < 8; ++it) { const int task = tid + it * NTHR, m = task >> 4, ch = task & 15; *(LAS v4u*)(R1 + m * 288 + 16 * ch) = kv[it]; }
#pragma unroll
            for (int it = 0; it < 4; ++it) { const int task = tid + it * NTHR, q = task >> 4, ch = task & 15; *(LAS v4u*)(R2 + q * 288 + 16 * ch) = qv[it]; } }
        __syncthreads();
#pragma unroll 1
        for (int ks = 0; ks < 4; ++ks) { const bf16x8 qf = *(const LAS bf16x8*)(R2 + i * 288 + 64 * ks + 16 * g);
#pragma unroll
            for (int mt = 0; mt < 16; ++mt) { const bf16x8 kf = *(const LAS bf16x8*)(R1 + (16 * mt + n) * 288 + 64 * ks + 16 * g); sacc[mt] = mfma16(kf, qf, sacc[mt]); } }
    }
    float mx = -INFINITY;
#pragma unroll
    for (int mt = 0; mt < 16; ++mt)
#pragma unroll
        for (int r = 0; r < 4; ++r) mx = fmaxf(mx, sacc[mt][r]);
    mx = fmaxf(mx, __shfl_xor(mx, 16)); mx = fmaxf(mx, __shfl_xor(mx, 32));
    float sm = 0.f;
#pragma unroll
    for (int mt = 0; mt < 16; ++mt)
#pragma unroll
        for (int r = 0; r < 4; ++r) { const float e = exp2f((sacc[mt][r] - mx) * 1.4426950408889634f); sacc[mt][r] = e; sm += e; }
    sm += __shfl_xor(sm, 16); sm += __shfl_xor(sm, 32);
    const float inv = 1.f / sm;
    __syncthreads();
#pragma unroll
    for (int mt = 0; mt < 16; ++mt) *(LAS v2u*)(R2 + i * 544 + (16 * mt + 4 * g) * 2) = pack4(sacc[mt][0] * inv, sacc[mt][1] * inv, sacc[mt][2] * inv, sacc[mt][3] * inv);
    f32x4 oacc[16];
#pragma unroll
    for (int dt = 0; dt < 16; ++dt) oacc[dt] = (f32x4){0.f, 0.f, 0.f, 0.f};
    for (int hh = 0; hh < 2; ++hh) {
        if (hh) __syncthreads();
        {   v4u vv[8];
#pragma unroll
            for (int it = 0; it < 8; ++it) { const int task = tid + it * NTHR, d = task >> 4, ch = task & 15; vv[it] = *(const v4u*)(mvT + (size_t)(head * 256 + d) * 512 + b * MEML + 128 * hh + 8 * ch); }
#pragma unroll
            for (int it = 0; it < 8; ++it) { const int task = tid + it * NTHR, d = task >> 4, ch = task & 15; *(LAS v4u*)(R1 + d * 288 + 16 * ch) = vv[it]; } }
        __syncthreads();
#pragma unroll 1
        for (int ks = 0; ks < 4; ++ks) { const bf16x8 pf = *(const LAS bf16x8*)(R2 + i * 544 + (128 * hh + 32 * ks + 8 * g) * 2);
#pragma unroll
            for (int dt = 0; dt < 16; ++dt) { const bf16x8 vf = *(const LAS bf16x8*)(R1 + (16 * dt + n) * 288 + 64 * ks + 16 * g); oacc[dt] = mfma16(vf, pf, oacc[dt]); } }
    }
    bf16* yp = WSP(bf16, WS_Y) + (size_t)(bt0 + i) * DM + 3072 + head * 256 + 4 * g;
#pragma unroll
    for (int dt = 0; dt < 16; ++dt) *(v2u*)(yp + 16 * dt) = pack4(oacc[dt][0], oacc[dt][1], oacc[dt][2], oacc[dt][3]);
    __syncthreads();
}
__device__ __forceinline__ int a3_next(LAS unsigned* qhead, int lane) {
    int v = 0; if (lane == 0) v = (int)__hip_atomic_fetch_add(qhead, 1u, __ATOMIC_RELAXED, __HIP_MEMORY_SCOPE_WORKGROUP);
    return __builtin_amdgcn_readfirstlane(v);
}
__device__ __forceinline__ void phase2c(const Params& p, LAS unsigned char* lds, int tid, int wave, int lane) {
#ifndef SUBREP
#define SUBREP 0
#endif
    for (int rep = 0; rep < ((SUBREP & 1) ? 2 : 1); ++rep)
    for (int it = blockIdx.x; it < 512; it += gridDim.x) r3_item(p, lds, it, tid, wave, lane);
    for (int rep = 0; rep < ((SUBREP & 2) ? 2 : 1); ++rep)
    for (int it = blockIdx.x; it < 256; it += gridDim.x) m_item(p, lds, it, tid, wave, lane);
    const int NGW = gridDim.x * NWAVES;
    a3_tables(p, lds, tid);
    constexpr int NQW = 6;
    LAS unsigned* qhead = (LAS unsigned*)(lds + LDSCTL_OFF) + 8;
    if (wave >= NQW) convert_rows_wave(p, (int)blockIdx.x * (NWAVES - NQW) + (wave - NQW), (int)gridDim.x * (NWAVES - NQW), lane);
    {
        const int xb = blockIdx.x & 1, step = NGW >> 1, t00 = (blockIdx.x >> 1) * NWAVES, nj = NWAVES * (SEQ / step);
        A3In nx; int j = a3_next(qhead, lane);
        if (j < nj) a3_fetch(p, xb * SEQ + t00 + (j & 7) + (j >> 3) * step, lane, nx);
        while (j < nj) { const A3In cur = nx; const int jn = a3_next(qhead, lane);
            if (jn < nj) a3_fetch(p, xb * SEQ + t00 + (jn & 7) + (jn >> 3) * step, lane, nx);
            a3_query(p, lds, xb * SEQ + t00 + (j & 7) + (j >> 3) * step, wave, lane, cur); j = jn; }
    }
}

__device__ __forceinline__ int ord_key(float v) { const int b = __float_as_int(v); return b ^ ((b >> 31) & 0x7fffffff); }
__device__ __forceinline__ float ord_val(int k) { return __int_as_float(k ^ ((k >> 31) & 0x7fffffff)); }
__device__ __forceinline__ int med3i(int a, int b, int c) { int r; asm("v_med3_i32 %0, %1, %2, %3" : "=v"(r) : "v"(a), "v"(b), "v"(c)); return r; }
#define KINS16(tv, vin) do { const int v_ = (vin); _Pragma("unroll") for (int k_ = 15; k_ >= 1; --k_) tv[k_] = med3i(tv[k_ - 1], tv[k_], v_); tv[0] = max(tv[0], v_); } while (0)
#define KMERGE16(a, b) do { _Pragma("unroll") for (int i_ = 0; i_ < 16; ++i_) a[i_] = max(a[i_], b[15 - i_]); \
    _Pragma("unroll") for (int st_ = 8; st_ >= 1; st_ >>= 1) { _Pragma("unroll") for (int i_ = 0; i_ < 16; ++i_) if ((i_ & st_) == 0) { const int hi_ = max(a[i_], a[i_ + st_]), lo_ = min(a[i_], a[i_ + st_]); a[i_] = hi_; a[i_ + st_] = lo_; } } } while (0)
constexpr int P7_IL = 133120;
__device__ __forceinline__ void p7_item(const Params& p, LAS unsigned char* lds, int item, int tid, int wave, int lane) {
    const int tb = item >> 3, h = item & 7, t0 = tb * 128;
    LAS unsigned char* Al = lds; LAS unsigned char* Bl = lds + 69632;
    const bf16* qp = WSP(const bf16, WS_QP); const bf16* skb = WSP(const bf16, WS_SKB);
    {   v4u qa[8], kb[8];
#pragma unroll
        for (int it = 0; it < 8; ++it) { const int task = tid + it * NTHR, tt = task >> 5, ch = task & 31; qa[it] = *(const v4u*)(qp + (size_t)(t0 + tt) * 2048 + h * 256 + 8 * ch); }
#pragma unroll
        for (int it = 0; it < 8; ++it) { const int task = tid + it * NTHR, rr = task >> 4, ch = task & 15; kb[it] = *(const v4u*)(skb + (size_t)(h * 256 + rr) * 128 + 8 * ch); }
#pragma unroll
        for (int it = 0; it < 8; ++it) { const int task = tid + it * NTHR, tt = task >> 5, ch = task & 31; *(LAS v4u*)(Al + tt * 544 + 16 * ch) = qa[it]; }
#pragma unroll
        for (int it = 0; it < 8; ++it) { const int task = tid + it * NTHR, rr = task >> 4, ch = task & 15; *(LAS v4u*)(Bl + rr * 288 + 16 * ch) = kb[it]; } }
    __syncthreads();
    const int g = lane >> 4, n = lane & 15;
    f32x4 acc[2][8];
#pragma unroll
    for (int c = 0; c < 2; ++c)
#pragma unroll
        for (int nt = 0; nt < 8; ++nt) { acc[c][nt] = (f32x4){0.f, 0.f, 0.f, 0.f};
#pragma unroll
            for (int ks = 0; ks < 4; ++ks) { const bf16x8 af = *(const LAS bf16x8*)(Al + (16 * wave + n) * 544 + (c * 128 + 32 * ks + 8 * g) * 2);
                const bf16x8 bf = *(const LAS bf16x8*)(Bl + (c * 128 + 16 * nt + n) * 288 + 64 * ks + 16 * g); acc[c][nt] = mfma16(af, bf, acc[c][nt]); } }
    __syncthreads();
    LAS float* sl = (LAS float*)lds;
#pragma unroll
    for (int c = 0; c < 2; ++c)
#pragma unroll
        for (int nt = 0; nt < 8; ++nt)
#pragma unroll
            for (int r = 0; r < 4; ++r) sl[(2 * (16 * wave + 4 * g + r) + c) * 129 + 16 * nt + n] = acc[c][nt][r];
    __syncthreads();
    {
        const int row = tid >> 1, hf = tid & 1, c = row & 1, tt = row >> 1;
        const LAS float* sr = sl + row * 129 + 64 * hf;
        int ta[16], tb2[16];
#pragma unroll
        for (int k = 0; k < 16; ++k) { ta[k] = (int)0x80000000; tb2[k] = (int)0x80000000; }
#pragma unroll 4
        for (int j = 0; j < 64; j += 2) { const int ka = (ord_key(sr[j]) & ~127) | (127 - (64 * hf + j)), kb = (ord_key(sr[j + 1]) & ~127) | (127 - (64 * hf + j + 1)); KINS16(ta, ka); KINS16(tb2, kb); }
        KMERGE16(ta, tb2);
#pragma unroll
        for (int k = 0; k < 16; ++k) tb2[k] = __shfl_xor(ta[k], 1);
        KMERGE16(ta, tb2);
        if (hf == 0) { v4u w;
#pragma unroll
            for (int e = 0; e < 4; ++e) w[e] = (unsigned)(127 - (ta[4 * e] & 127)) | ((unsigned)(127 - (ta[4 * e + 1] & 127)) << 8) | ((unsigned)(127 - (ta[4 * e + 2] & 127)) << 16) | ((unsigned)(127 - (ta[4 * e + 3] & 127)) << 24);
            *(LAS v4u*)(lds + P7_IL + row * 16) = w; }
#pragma unroll
        for (int k = 0; k < 16; ++k) tb2[k] = __shfl_xor(ta[k], 2);
        float s0[16], s1[16];
#pragma unroll
        for (int k = 0; k < 16; ++k) { s0[k] = ord_val(c ? tb2[k] : ta[k]); s1[k] = ord_val(c ? ta[k] : tb2[k]); }
        int ca[16], cb[16];
#pragma unroll
        for (int k = 0; k < 16; ++k) { ca[k] = (int)0x80000000; cb[k] = (int)0x80000000; }
        int cnt = 0;
#pragma unroll
        for (int a = 0; a < 16; ++a)
#pragma unroll
            for (int bq = 0; bq < 16; ++bq) if ((a + 1) * (bq + 1) <= 16) { const int kk = (ord_key(s0[a] + s1[bq]) & ~255) | (255 - (16 * a + bq)); if (cnt & 1) { KINS16(cb, kk); } else { KINS16(ca, kk); } ++cnt; }
        KMERGE16(ca, cb);
        LDS_WAIT(); asm volatile("" ::: "memory");
        if ((tid & 3) == 0) {
            const LAS unsigned char* i0 = lds + P7_IL + (2 * tt) * 16; const LAS unsigned char* i1 = lds + P7_IL + (2 * tt + 1) * 16;
            const float mx = ord_val(ca[0]); float ev[16], sum = 0.f; int ex[16];
#pragma unroll
            for (int k = 0; k < 16; ++k) { ev[k] = __expf(ord_val(ca[k]) - mx); sum += ev[k]; const int flat = 255 - (ca[k] & 255); ex[k] = (int)i0[flat >> 4] * 128 + (int)i1[flat & 15]; }
            const float inv = 1.f / sum;
            int* eo = WSP(int, WS_EIDX) + (size_t)(t0 + tt) * 128 + h * 16; float* go = WSP(float, WS_EGATE) + (size_t)(t0 + tt) * 128 + h * 16;
#pragma unroll
            for (int k = 0; k < 16; ++k) { eo[k] = ex[k]; go[k] = ev[k] * inv; }
        }
    }
    __syncthreads();
}

typedef _Float16 h16x2 __attribute__((ext_vector_type(2)));
#define FP4_H2(word, sel) __builtin_amdgcn_cvt_scalef32_pk_f16_fp4((word), 1.0f, (sel))
__device__ __forceinline__ float gelu_erf(float v) {
    const float av = fabsf(v), t = __builtin_amdgcn_rcpf(av * 0.2316418882f + 1.0f);
    float q = t * 0.5307027145f + (-0.7265760135f); q = q * t + 0.7107068705f; q = q * t + (-0.142248368f); q = q * t + 0.127414796f; q = q * t;
    const float e = __builtin_amdgcn_exp2f((v * v) * (-0.72134752044f)), m = v * (q * e);
    return v < 0.f ? m : v - m;
}
__device__ __forceinline__ float group16_sum(float v) { v += dpp_f<0xB1>(v); v += dpp_f<0x4E>(v); v += dpp_f<0x141>(v); v += dpp_f<0x140>(v); return v; }
typedef int i32x4v __attribute__((ext_vector_type(4)));
typedef int i32x8v __attribute__((ext_vector_type(8)));
constexpr int P8_TROW = 288, P8_TILE = 32 * P8_TROW;
__device__ __forceinline__ void p8_dots_mfma(const unsigned char* tus, const LAS int* eiw, const unsigned char* xrow8, LAS float* hl, LAS unsigned char* tl, int lane) {
    const int m = lane & 15, kb = lane >> 4;
    i32x8v xb[4];
#pragma unroll
    for (int ks = 0; ks < 4; ++ks) { const i32x4v xlo = *(const i32x4v*)(xrow8 + 128 * ks + 16 * kb), xhi = *(const i32x4v*)(xrow8 + 128 * ks + 64 + 16 * kb); xb[ks] = __builtin_shufflevector(xlo, xhi, 0, 1, 2, 3, 4, 5, 6, 7); }
    const int one = 0x7F7F7F7F;
    i32x4v nd[8], nsc;
#define P8_TFETCH(T) do { _Pragma("unroll") for (int i_ = 0; i_ < 8; ++i_) nd[i_] = *(const i32x4v*)(tus + (size_t)eiw[2 * (32 * (T) + 4 * i_ + kb)] * XSL + 16 * m); \
        nsc = *(const i32x4v*)(tus + (size_t)eiw[2 * (32 * (T) + (lane & 31))] * XSL + 256); } while (0)
    P8_TFETCH(0);
#pragma unroll
    for (int T = 0; T < 4; ++T) {
#pragma unroll
        for (int i = 0; i < 8; ++i) *(LAS i32x4v*)(tl + (4 * i + kb) * P8_TROW + 16 * m) = nd[i];
        if (lane < 32) *(LAS i32x4v*)(tl + lane * P8_TROW + 256) = nsc;
        if (T < 3) P8_TFETCH(T + 1);
        LDS_WAIT(); asm volatile("" ::: "memory");
        f32x4 acc0 = (f32x4){0.f, 0.f, 0.f, 0.f}, acc1 = acc0;
#pragma unroll
        for (int ks = 0; ks < 4; ++ks) {
            const i32x4v p0 = *(const LAS i32x4v*)(tl + m * P8_TROW + 64 * ks + 16 * kb), p1 = *(const LAS i32x4v*)(tl + (16 + m) * P8_TROW + 64 * ks + 16 * kb);
            const unsigned s0 = *(const LAS unsigned*)(tl + m * P8_TROW + 256 + 4 * ks), s1 = *(const LAS unsigned*)(tl + (16 + m) * P8_TROW + 256 + 4 * ks);
            const int sa0 = (int)(((s0 >> (8 * kb)) & 0xffu) * 0x01010101u), sa1 = (int)(((s1 >> (8 * kb)) & 0xffu) * 0x01010101u);
            asm volatile("s_nop 1\n\tv_mfma_scale_f32_16x16x128_f8f6f4 %0, %1, %2, %0, %3, %4 op_sel_hi:[0,0,0] cbsz:4" : "+v"(acc0) : "v"(p0), "v"(xb[ks]), "v"(sa0), "v"(one));
            asm volatile("s_nop 1\n\tv_mfma_scale_f32_16x16x128_f8f6f4 %0, %1, %2, %0, %3, %4 op_sel_hi:[0,0,0] cbsz:4" : "+v"(acc1) : "v"(p1), "v"(xb[ks]), "v"(sa1), "v"(one));
        }
        asm volatile("s_nop 15\n\ts_nop 15\n\ts_nop 15" : "+v"(acc0), "+v"(acc1));
        if (m == 0) {
            LAS f32x4* hp0 = (LAS f32x4*)(hl + 32 * T + 4 * kb); *hp0 = *hp0 + acc0;
            LAS f32x4* hp1 = (LAS f32x4*)(hl + 32 * T + 16 + 4 * kb); *hp1 = *hp1 + acc1; }
        LDS_WAIT(); asm volatile("" ::: "memory");
    }
#undef P8_TFETCH
}
__device__ __forceinline__ void p8_axpy(const unsigned char* tvs, const LAS v2u* eaw, h16x2 (&acc)[16], int lane) {
    const int j = lane & 15, g = lane >> 4;
#pragma unroll 1
    for (int b8 = 0; b8 < 4; ++b8) {
        v4u w[8]; unsigned sc[8]; float av[8];
#pragma unroll
        for (int q = 0; q < 8; ++q) { const int i = 8 * b8 + q; const v2u ea = eaw[(i >= 16 ? 64 : 0) + 4 * (i & 15) + g]; av[q] = __uint_as_float(ea.y);
            const unsigned char* rp = tvs + (size_t)ea.x * XSL; w[q] = *(const v4u*)(rp + 16 * j); sc[q] = rp[256 + j]; }
#pragma unroll
        for (int q = 0; q < 8; ++q) { const _Float16 as = (_Float16)(av[q] * __uint_as_float(sc[q] << 23)); const h16x2 asv = (h16x2){as, as};
#pragma unroll
            for (int c = 0; c < 4; ++c) { acc[4 * c + 0] = FP4_H2(w[q][c], 0) * asv + acc[4 * c + 0]; acc[4 * c + 1] = FP4_H2(w[q][c], 1) * asv + acc[4 * c + 1];
                acc[4 * c + 2] = FP4_H2(w[q][c], 2) * asv + acc[4 * c + 2]; acc[4 * c + 3] = FP4_H2(w[q][c], 3) * asv + acc[4 * c + 3]; } }
    }
}
__device__ __forceinline__ size_t p8_out_off(int t, int s, int lane) { return (size_t)t * DM + 512 * s + 32 * (lane & 15) + 8 * (lane >> 4); }
__device__ __forceinline__ void p8_out(float* outbase, const v4u xb, int t, int s, int lane, h16x2 (&acc)[16]) {
    const int j = lane & 15, g = lane >> 4;
#pragma unroll
    for (int c = 0; c < 16; ++c) { union { h16x2 h; int i; } u, v; u.h = acc[c]; v.i = __shfl_xor(u.i, 16); u.h = u.h + v.h; v.i = __shfl_xor(u.i, 32); acc[c] = u.h + v.h; }
    h16x2 q[4];
#pragma unroll
    for (int c = 0; c < 4; ++c) q[c] = g == 0 ? acc[c] : (g == 1 ? acc[4 + c] : (g == 2 ? acc[8 + c] : acc[12 + c]));
    f32x4* op = (f32x4*)(outbase + p8_out_off(t, s, lane));
    op[0] = (f32x4){bflo(xb.x), bfhi(xb.x), bflo(xb.y), bfhi(xb.y)} + (f32x4){(float)q[0][0], (float)q[0][1], (float)q[1][0], (float)q[1][1]};
    op[1] = (f32x4){bflo(xb.z), bfhi(xb.z), bflo(xb.w), bfhi(xb.w)} + (f32x4){(float)q[2][0], (float)q[2][1], (float)q[3][0], (float)q[3][1]};
}
__device__ __forceinline__ void p8_wave(const Params& p, LAS unsigned char* wlds, int t0, int tstride, int lane, float* outbase) {
    const int j = lane & 15, g4 = lane >> 4;
    const unsigned char* TU = WSP(const unsigned char, WS_U8); const unsigned char* TV = WSP(const unsigned char, WS_V8);
    LAS v2u* ea = (LAS v2u*)wlds;
    float rs[4];
#pragma unroll
    for (int q = 0; q < 4; ++q) { const int t = t0 + q * tstride; const int tt = t < NT ? t : t0;
        const int* ei = WSP(const int, WS_EIDX) + (size_t)tt * 128;
        ea[q * 128 + lane] = (v2u){(unsigned)ei[lane], 0u}; ea[q * 128 + 64 + lane] = (v2u){(unsigned)ei[64 + lane], 0u};
        rs[q] = rsqrtf(wave_sum_dpp(WSP(const float, WS_PART)[(size_t)tt * 64 + lane]) * (1.f / 4096.f) + EPS); }
    LDS_WAIT(); asm volatile("" ::: "memory");
    LAS float* hl = (LAS float*)(wlds + 4096);
#pragma unroll
    for (int q = 0; q < 8; ++q) hl[64 * q + lane] = 0.f;
    LDS_WAIT(); asm volatile("" ::: "memory");
#pragma unroll 1
    for (int s = 0; s < 8; ++s) {
        const unsigned char* tus = TU + (size_t)s * XSLICE;
#pragma unroll
        for (int q = 0; q < 4; ++q) { const int t = t0 + q * tstride; p8_dots_mfma(tus, (const LAS int*)(wlds + q * 1024), WSP(const unsigned char, WS_XN8) + (size_t)(t < NT ? t : t0) * DM + 512 * s, hl + 128 * q, wlds + 6144, lane); }
    }
    LDS_WAIT(); asm volatile("" ::: "memory");
#pragma unroll
    for (int q = 0; q < 4; ++q) { const int t = t0 + q * tstride; const bool ok = t < NT; const float* eg = WSP(const float, WS_EGATE) + (size_t)(ok ? t : t0) * 128;
#pragma unroll
        for (int hh = 0; hh < 2; ++hh) { const int slot = 64 * hh + lane; const float a = ok ? gelu_erf(hl[128 * q + slot] * rs[q]) * eg[slot] : 0.f; ((LAS unsigned*)ea)[2 * (q * 128 + slot) + 1] = __float_as_uint(a); } }
    LDS_WAIT(); asm volatile("" ::: "memory");
#pragma unroll 1
    for (int s = 0; s < 8; ++s) {
        const unsigned char* tvs = TV + (size_t)s * XSLICE;
#pragma unroll
        for (int q = 0; q < 4; ++q) { const int t = t0 + q * tstride;
            h16x2 acc[16];
#pragma unroll
            for (int c = 0; c < 16; ++c) acc[c] = (h16x2){(_Float16)0.f, (_Float16)0.f};
            const v4u xb = *(const v4u*)(WSP(const bf16, WS_X1B) + p8_out_off(t < NT ? t : t0, s, lane));
            p8_axpy(tvs, ea + q * 128, acc, lane);
            if (t < NT) p8_out(outbase, xb, t, s, lane, acc); }
    }
    LDS_WAIT(); asm volatile("" ::: "memory");
}

#define CAS __attribute__((address_space(4)))
template <class T> __device__ __forceinline__ T* as_global(T* q) { GAS T* g = (GAS T*)q; asm volatile("" : "+s"(g)); return (T*)g; }
__device__ __forceinline__ Params load_params(const CAS char* kp) {
#if defined(__HIP_DEVICE_COMPILE__)
    unsigned off = 0; asm volatile("" : "+s"(off));
    const CAS unsigned long long* q = (const CAS unsigned long long*)(kp + off);
    union { Params p; unsigned long long w[sizeof(Params) / 8]; } u;
#pragma unroll
    for (int i = 0; i < (int)(sizeof(Params) / 8); ++i) u.w[i] = q[i];
    Params r = u.p;
#define GLOBALIZE(f) r.f = as_global(r.f)
    GLOBALIZE(x); GLOBALIZE(mem); GLOBALIZE(pos); GLOBALIZE(ln1_g); GLOBALIZE(w_in); GLOBALIZE(att_q_g); GLOBALIZE(att_k_g); GLOBALIZE(rel_bias); GLOBALIZE(mem_g); GLOBALIZE(w_mem_kv); GLOBALIZE(mem_q_g);
    GLOBALIZE(mem_k_g); GLOBALIZE(w_up_ret); GLOBALIZE(w_up_att); GLOBALIZE(w_up_mem); GLOBALIZE(w_out); GLOBALIZE(ln2_g); GLOBALIZE(peer_w_q); GLOBALIZE(peer_sub_keys); GLOBALIZE(peer_u); GLOBALIZE(peer_v);
    GLOBALIZE(out); GLOBALIZE(ws);
#undef GLOBALIZE
    return r;
#else
    return Params{};
#endif
}
static_assert(sizeof(Params) % 8 == 0, "Params is a whole number of 8-byte words");
#define PP() load_params(kp)
__global__ void __launch_bounds__(NTHR, 2) fwd(Params p_arg) {
    const CAS char* kp = (const CAS char*)__builtin_amdgcn_kernarg_segment_ptr();
    extern __shared__ __attribute__((aligned(16))) unsigned char lds_raw[];
    LAS unsigned char* lds = (LAS unsigned char*)lds_raw;
    const int tid = threadIdx.x, lane = tid & 63, wave = __builtin_amdgcn_readfirstlane(tid >> 6);
    if (tid < 64) ((LAS unsigned*)(lds + LDSCTL_OFF))[tid] = 0u;
    __syncthreads();
    XcdBarrier bar; int lo, hi;
    { const Params p = PP(); bar = xcd_barrier_post(WSP(unsigned, WS_CTL) + CW_BAR + p.li * XCD_BAR_WORDS, (volatile LAS unsigned*)(lds + LDSCTL_OFF)); lo = p.ph_lo; hi = p.ph_hi; }
#if defined(SKIP_MASK)
#define IN(k) (!((SKIP_MASK >> (k)) & 1) && lo <= (k) && (k) < hi)
#elif defined(ONLY_PH)
#define IN(k) ((k) == ONLY_PH && lo <= (k) && (k) < hi)
#else
#define IN(k) (lo <= (k) && (k) < hi)
#endif
#define SEAM(k) do { if (IN(k) && IN((k) + 1)) xcd_barrier(bar); } while (0)
#ifndef REPEAT_MASK
#define REPEAT_MASK 0
#endif
#define REPS(k) for (int rep_ = 0; rep_ < ((((REPEAT_MASK) >> (k)) & 1) ? 2 : 1); ++rep_)
#define REPBAR() do { if (rep_) xcd_barrier(bar); } while (0)
    if (IN(0)) REPS(0) { REPBAR(); const Params p = PP(); phase0(p, lds, tid, wave, lane); }
    SEAM(0);
    if (IN(1)) REPS(1) { REPBAR();
        const Params p = PP();
        { pg8::Gemm g{WSP(const pg8::bf16_t, WS_R8), WSP(const pg8::bf16_t, WS_R8), 8192, 22016, 4096}; pg8::OrderP1b S; S.init((int)gridDim.x, (int)blockIdx.x);
          LAS unsigned char* lut = lds + 131072;
          for (int i = tid; i < 4097; i += NTHR) lut[i] = (unsigned char)pg8::EpiP1b::sig_u8_exact(-8.f + (float)i * (1.f / 256.f));
          __syncthreads();
          pg8::EpiP1b E{WSP(pg8::bf16_t, WS_PROJ), WSP(pg8::bf16_t, WS_MK), WSP(pg8::bf16_t, WS_MVT), WSP(unsigned char, WS_SG), lut};
          pg8::gemm_phase_f8<pg8::EpiP1b, pg8::OrderP1b, true, true>(lds, g, S, E); }
    }
    SEAM(1);
    if (IN(2)) REPS(2) { REPBAR(); const Params p = PP(); phase2a(p, lds, tid, wave, lane); }
    SEAM(2);
    if (IN(3)) REPS(3) { REPBAR(); const Params p = PP(); phase2b(p, lds, tid, wave, lane); }
    SEAM(3);
    if (IN(4)) REPS(4) { REPBAR(); const Params p = PP(); phase2c(p, lds, tid, wave, lane); }
    SEAM(4);
    if (IN(5)) REPS(5) { REPBAR();
        const Params p = PP();
        pg8::Gemm g{WSP(const pg8::bf16_t, WS_Y), WSP(const pg8::bf16_t, WS_WUP), 8192, 4096, 4096}; pg8::OrderUp S; S.init((int)gridDim.x, (int)blockIdx.x);
        pg8::EpiUp E{WSP(const unsigned char, WS_SG), WSP(pg8::bf16_t, WS_MERGED), {}};
        pg8::gemm_phase<pg8::EpiUp, pg8::OrderUp, true, true>(lds, g, S, E);
    }
    SEAM(5);
    if (IN(6)) REPS(6) { REPBAR();
        const Params p = PP();
        pg8::Gemm g{WSP(const pg8::bf16_t, WS_MERGED), WSP(const pg8::bf16_t, WS_WOUT), 8192, 4096, 4096}; pg8::StaticOrder S; S.init(8192, 4096, (int)gridDim.x, (int)blockIdx.x);
        pg8::EpiResF32 E{p.x, WSP(pg8::bf16_t, WS_X1B), WSP(float, WS_PART), WSP(unsigned char, WS_XN8)};
        pg8::gemm_phase<pg8::EpiResF32, pg8::StaticOrder, true, true>(lds, g, S, E);
    }
    do { if (IN(6) && IN(8)) xcd_barrier(bar); } while (0);
    if (IN(8)) REPS(8) { REPBAR();
        const Params p = PP();
        pg8::Gemm g{WSP(const pg8::bf16_t, WS_X1B), WSP(const pg8::bf16_t, WS_WQ), 8192, 2048, 4096}; pg8::StaticOrder S; S.init(8192, 2048, (int)gridDim.x, (int)blockIdx.x);
        pg8::EpiStoreBf16Rs E{WSP(pg8::bf16_t, WS_QP), 2048, WSP(const float, WS_PART)};
        pg8::gemm_phase<pg8::EpiStoreBf16Rs, pg8::StaticOrder, true, true>(lds, g, S, E);
    }
    if (IN(9)) {
        const Params p = PP();
        const bool own = IN(8) && gridDim.x == 256;
        if (IN(8) && !own) xcd_barrier(bar);
        int base = (int)blockIdx.x, stride = (int)gridDim.x, cnt = (512 - base + stride - 1) / stride;
        if (own) {
            __builtin_amdgcn_fence(__ATOMIC_RELEASE, "workgroup"); __syncthreads(); __builtin_amdgcn_fence(__ATOMIC_ACQUIRE, "workgroup");
            pg8::StaticOrder S; S.init(8192, 2048, (int)gridDim.x, (int)blockIdx.x); pg8::Unit u; S.next(0, u);
            base = __builtin_amdgcn_readfirstlane(2 * u.pm * 8 + u.pn); stride = 8; cnt = 2;
        }
#pragma unroll 1
        for (int j = 0; j < cnt; ++j) p7_item(p, lds, base + j * stride, tid, wave, lane);
    }
    SEAM(9);
    if (IN(10)) REPS(10) { REPBAR(); const Params p = PP(); const int gw = blockIdx.x * NWAVES + wave, NGW = gridDim.x * NWAVES;
        for (int t0 = gw; t0 < NT; t0 += 4 * NGW) p8_wave(p, lds + wave * 15360, t0, NGW, lane, (((REPEAT_MASK) >> 10) & 1) && rep_ == 0 ? WSP(float, WS_R) : p.out); }
#undef IN
#undef SEAM
}

extern "C" void kernel_launch(void* const* d_in, const int* in_sizes, int n_in, void* d_out, int out_size, void* d_ws, size_t ws_size, hipStream_t stream) {
    static int grid = 0;
    if (grid == 0) {
        if (n_in != 21 || out_size != NT * DM || ws_size < WS_END) { fprintf(stderr, "kernel_launch: unexpected shapes (n_in %d, out %d, ws %zu)\n", n_in, out_size, ws_size); grid = -1; return; }
        int dev = 0, cus = 0, per_cu = 0;
        if (hipGetDevice(&dev) != hipSuccess || hipDeviceGetAttribute(&cus, hipDeviceAttributeMultiprocessorCount, dev) != hipSuccess) { grid = -1; return; }
        if (hipFuncSetAttribute((const void*)fwd, hipFuncAttributeMaxDynamicSharedMemorySize, LDS_BYTES) != hipSuccess) { fprintf(stderr, "kernel_launch: hipFuncSetAttribute failed\n"); grid = -1; return; }
        if (hipOccupancyMaxActiveBlocksPerMultiprocessor(&per_cu, (const void*)fwd, NTHR, LDS_BYTES) != hipSuccess || per_cu < 1) fprintf(stderr, "kernel_launch: occupancy query reports %d workgroups per CU\n", per_cu);
        (void)hipGetLastError();
        grid = cus;
    }
    if (grid < 0) return;
    if (hipMemsetAsync((char*)d_ws + WS_CTL, 0, CTL_ZERO_BYTES, stream) != hipSuccess) return;
    Params p{};
    p.x = (const float*)d_in[0]; p.mem = (const float*)d_in[1]; p.pos = (const int*)d_in[2]; p.ln1_g = (const float*)d_in[3]; p.w_in = (const float*)d_in[4];
    p.att_q_g = (const float*)d_in[5]; p.att_k_g = (const float*)d_in[6]; p.rel_bias = (const float*)d_in[7]; p.mem_g = (const float*)d_in[8]; p.w_mem_kv = (const float*)d_in[9];
    p.mem_q_g = (const float*)d_in[10]; p.mem_k_g = (const float*)d_in[11]; p.w_up_ret = (const float*)d_in[12]; p.w_up_att = (const float*)d_in[13]; p.w_up_mem = (const float*)d_in[14];
    p.w_out = (const float*)d_in[15]; p.ln2_g = (const float*)d_in[16]; p.peer_w_q = (const float*)d_in[17]; p.peer_sub_keys = (const float*)d_in[18]; p.peer_u = (const float*)d_in[19]; p.peer_v = (const float*)d_in[20];
    p.out = (float*)d_out; p.ws = (unsigned char*)d_ws; p.pad = 0;
#if MK_PER_PHASE
    for (int li = 0; li < NPH; ++li) { p.ph_lo = li; p.ph_hi = li + 1; p.li = li; hipLaunchKernelGGL(fwd, dim3(grid), dim3(NTHR), LDS_BYTES, stream, p); }
#else
    p.ph_lo = 0; p.ph_hi = NPH; p.li = 0; hipLaunchKernelGGL(fwd, dim3(grid), dim3(NTHR), LDS_BYTES, stream, p);
#endif
}
```

```cpp
#include <hip/hip_runtime.h>
#include <cstdio>
#include <cstdint>
namespace pg8 {
#define PG8_LAS __attribute__((address_space(3)))
typedef unsigned short bf16_t;
typedef short bf16x8 __attribute__((ext_vector_type(8)));
typedef float f32x4 __attribute__((ext_vector_type(4)));
typedef unsigned u32x4 __attribute__((ext_vector_type(4)));
constexpr int BM = 256, BK = 64, HALF = 128, HTB = HALF * BK * 2  , STAGE_BYTES = 8 * HTB, NXCD = 8, WGM = 8;

__host__ __device__ __forceinline__ int lds_byte(int r, int c) { const int st = (r >> 4) * 2 + (c >> 5), rr = r & 15, cc = c & 31, ob = rr * 64 + cc * 2; return st * 1024 + (ob ^ (((ob >> 9) & 1) << 5)); }
__host__ __device__ __forceinline__ void stage_rc(int b, int& R, int& C) { const int st = b / 1024, sb = b % 1024, swz = sb ^ (((sb >> 9) & 1) << 5); R = (st >> 1) * 16 + swz / 64; C = (st & 1) * 32 + (swz % 64) / 2; }
__host__ __device__ __forceinline__ int perm32(int rho) { const int n = rho >> 4, i = rho & 15; return 8 * (i >> 2) + 4 * n + (i & 3); }

struct Unit { int pm, pn, kt0, nkt, keep; };
struct Gemm { const bf16_t* A; const bf16_t* Bt; int M, N, K; };

struct StaticOrder {
    int nM, nN, nwg, G, c;
    __host__ __device__ void init(int M, int N, int G_, int c_) { nM = M / BM; nN = N / BM; nwg = nM * nN; G = G_; c = c_; }
    __host__ __device__ __forceinline__ bool next(int i, Unit& u) const {
        const long L = (long)i * G + c; if (L >= nwg) return false;
        int wgid = (int)L; { const int q = nwg / NXCD, r = nwg % NXCD, xcd = wgid % NXCD, off = wgid / NXCD; wgid = (xcd < r ? xcd * (q + 1) : r * (q + 1) + (xcd - r) * q) + off; }
        const int nig = WGM * nN, gid = wgid / nig, fm = gid * WGM, gsz = (nM - fm) < WGM ? (nM - fm) : WGM;
        u.pm = fm + ((wgid % nig) % gsz); u.pn = (wgid % nig) / gsz; u.kt0 = 0; u.nkt = 64; u.keep = 0; return true;
    }
    __device__ __forceinline__ void a_ready(const Unit&) const {}
    __device__ __forceinline__ void done(const Unit&) const {}
};

__device__ __forceinline__ unsigned cvt_pk_bf16(float lo, float hi) { unsigned r; asm volatile("v_cvt_pk_bf16_f32 %0, %1, %2" : "=v"(r) : "v"(lo), "v"(hi)); return r; }
__device__ __forceinline__ void store_tile_bf16(const f32x4 (&acc)[2][2][4][2], bf16_t* base, int ldc, int row0, int col0) {
#pragma unroll
    for (int ai = 0; ai < 2; ++ai)
#pragma unroll
        for (int m = 0; m < 4; ++m) { bf16_t* rowp = base + (size_t)(row0 + ai * HALF + m * 16) * ldc + col0;
#pragma unroll
            for (int bj = 0; bj < 2; ++bj) { const f32x4 v0 = acc[ai][bj][m][0], v1 = acc[ai][bj][m][1];
                u32x4 w; w.x = cvt_pk_bf16(v0[0], v0[1]); w.y = cvt_pk_bf16(v0[2], v0[3]); w.z = cvt_pk_bf16(v1[0], v1[1]); w.w = cvt_pk_bf16(v1[2], v1[3]);
                *(u32x4*)(rowp + bj * HALF) = w; } }
}
struct OrderP1a {
    StaticOrder so;
    __device__ void init(int G, int c) { so.init(8192, 6144, G, c); }
    __device__ bool next(int i, Unit& u) const { if (!so.next(i, u)) return false; u.pn += 32; return true; }
    __device__ __forceinline__ void a_ready(const Unit&) const {}
    __device__ __forceinline__ void done(const Unit&) const {}
};
struct EpiP1a {
    static constexpr bool PERM = true, AFTER_DRAIN = false;
    bf16_t* proj;
    __device__ __forceinline__ void operator()(const f32x4 (&acc)[2][2][4][2], const Unit& u, int wr, int wc, int fr, int fq) const {
        store_tile_bf16(acc, proj, 22016, u.pm * 256 + wr * 64 + fr, (u.pn - 32) * 256 + wc * 32 + 8 * fq);
    }
};
struct OrderP1b {
    StaticOrder so;
    __device__ void init(int G, int c) { so.init(8192, 22016, G, c); }
    __device__ bool next(int i, Unit& u) const {
        const long L = (long)i * so.G + so.c;
        if (L < so.nwg) { so.next(i, u); u.pn += 34; u.nkt = 32; return true; }
        const int e = (int)(L - so.nwg); if (e >= 16) return false;
        if (e < 8) { u.pm = 32 + (e & 1); u.pn = 120 + (e >> 1); } else { u.pm = 124 + ((e - 8) >> 1); u.pn = 32 + ((e - 8) & 1); }
        u.kt0 = 0; u.nkt = 32; u.keep = 0; return true;
    }
    __device__ __forceinline__ void a_ready(const Unit&) const {}
    __device__ __forceinline__ void done(const Unit&) const {}
};
struct EpiP1b {
    static constexpr bool PERM = true, AFTER_DRAIN = false;
    bf16_t *proj, *mk, *mvT; unsigned char* sg; const PG8_LAS unsigned char* lut;
    __device__ __forceinline__ static unsigned sig_u8_exact(float g) {
        const float s = __builtin_amdgcn_rcpf(1.f + __expf(-g)); unsigned q = (unsigned)__builtin_fmaf(s, 255.f, 0.5f); return q < 1u ? 1u : (q > 255u ? 255u : q); }
    __device__ __forceinline__ unsigned sig_u8(float g) const {
        const float fi = __builtin_amdgcn_fmed3f(__builtin_fmaf(g, 256.f, 2048.5f), 0.f, 4096.f); return (unsigned)lut[(int)fi]; }
    __device__ __forceinline__ void operator()(const f32x4 (&acc)[2][2][4][2], const Unit& u, int wr, int wc, int fr, int fq) const {
        if (u.pm >= 32) {
            bf16_t* base; int ldc, r0, c0;
            if (u.pm < 34) { base = mk; ldc = 1024; r0 = (u.pm - 32) * 256; c0 = (u.pn - 120) * 256; }
            else { base = mvT; ldc = 512; r0 = (u.pm - 124) * 256; c0 = (u.pn - 32) * 256; }
            store_tile_bf16(acc, base, ldc, r0 + wr * 64 + fr, c0 + wc * 32 + 8 * fq);
            return;
        }
        const int row0 = u.pm * 256 + wr * 64 + fr, col0 = (u.pn - 34) * 256 + wc * 32 + 8 * fq;
#pragma unroll
        for (int bj = 0; bj < 2; ++bj) { const int cg = col0 + bj * HALF;
            if (cg < 9552) {
#pragma unroll
                for (int ai = 0; ai < 2; ++ai)
#pragma unroll
                    for (int m = 0; m < 4; ++m) { const f32x4 v0 = acc[ai][bj][m][0], v1 = acc[ai][bj][m][1];
                        u32x4 w; w.x = cvt_pk_bf16(v0[0], v0[1]); w.y = cvt_pk_bf16(v0[2], v0[3]); w.z = cvt_pk_bf16(v1[0], v1[1]); w.w = cvt_pk_bf16(v1[2], v1[3]);
                        *(u32x4*)(proj + (size_t)(row0 + ai * HALF + m * 16) * 22016 + cg) = w; }
            } else if (cg < 21840) {
                const int gi = (cg - 9552) >> 12, gc = (cg - 9552) & 4095;
                unsigned char* sp = sg + ((size_t)gi * 8192 + row0) * 4096 + gc;
#pragma unroll
                for (int ai = 0; ai < 2; ++ai)
#pragma unroll
                    for (int m = 0; m < 4; ++m) { const f32x4 v0 = acc[ai][bj][m][0], v1 = acc[ai][bj][m][1];
                        typedef unsigned u32x2g __attribute__((ext_vector_type(2))); u32x2g w;
                        w.x = sig_u8(v0[0]) | (sig_u8(v0[1]) << 8) | (sig_u8(v0[2]) << 16) | (sig_u8(v0[3]) << 24);
                        w.y = sig_u8(v1[0]) | (sig_u8(v1[1]) << 8) | (sig_u8(v1[2]) << 16) | (sig_u8(v1[3]) << 24);
                        *(u32x2g*)(sp + (size_t)(ai * HALF + m * 16) * 4096) = w; }
            }
        }
    }
};
struct OrderUp {
    StaticOrder so;
    __device__ void init(int G, int c) { so.init(8192, 4096, G, c); }
    __device__ bool next(int i, Unit& u) const {
        const int round = i / 3, br = i - 3 * round;
        if (!so.next(round, u)) return false;
        u.kt0 = br == 0 ? 0 : (br == 1 ? 32 : 48); u.nkt = br == 0 ? 32 : 16; u.keep = br < 2 ? 1 : 0; return true;
    }
    __device__ __forceinline__ void a_ready(const Unit&) const {}
    __device__ __forceinline__ void done(const Unit&) const {}
};
struct EpiUp {
    static constexpr bool PERM = true, AFTER_DRAIN = false;
    const unsigned char* __restrict__ sg; bf16_t* __restrict__ merged;
    typedef unsigned u32x2g __attribute__((ext_vector_type(2)));
    mutable u32x2g keep[2][4][2];
    __device__ __forceinline__ void operator()(const f32x4 (&acc_in)[2][2][4][2], const Unit& u, int wr, int wc, int fr, int fq) const {
        f32x4 (&acc)[2][2][4][2] = const_cast<f32x4 (&)[2][2][4][2]>(acc_in);
        const int mode = u.kt0 == 0 ? 0 : (u.kt0 == 32 ? 1 : 2);
        const int row0 = u.pm * 256 + wr * 64 + fr, col0 = u.pn * 256 + wc * 32 + 8 * fq;
        const unsigned char* pa = sg + (size_t)row0 * 4096 + col0;
        const unsigned char* pb = sg + ((size_t)(mode < 2 ? mode + 1 : 2) * 8192 + row0) * 4096 + col0;
#pragma unroll
        for (int ai = 0; ai < 2; ++ai) {
            u32x2g ga[4][2], gb[4][2];
#pragma unroll
            for (int m = 0; m < 4; ++m)
#pragma unroll
                for (int bj = 0; bj < 2; ++bj) { const size_t off = (size_t)(ai * HALF + m * 16) * 4096 + bj * HALF;
                    ga[m][bj] = keep[ai][m][bj]; gb[m][bj] = keep[ai][m][bj];
                    if (mode == 0) ga[m][bj] = *(const u32x2g*)(pa + off);
                    if (mode < 2) gb[m][bj] = *(const u32x2g*)(pb + off); }
#pragma unroll
            for (int m = 0; m < 4; ++m)
#pragma unroll
                for (int bj = 0; bj < 2; ++bj) {
                    float f[8];
                    if (mode < 2) {
#pragma unroll
                        for (int e = 0; e < 8; ++e) { const float a = (float)((ga[m][bj][e >> 2] >> (8 * (e & 3))) & 0xffu), b = (float)((gb[m][bj][e >> 2] >> (8 * (e & 3))) & 0xffu);
                            f[e] = a * __builtin_amdgcn_rcpf(b); }
                    } else {
#pragma unroll
                        for (int e = 0; e < 8; ++e) f[e] = (float)((ga[m][bj][e >> 2] >> (8 * (e & 3))) & 0xffu) * (1.f / 255.f);
                    }
                    keep[ai][m][bj] = gb[m][bj];
                    f32x4 v0 = acc[ai][bj][m][0], v1 = acc[ai][bj][m][1];
                    v0[0] *= f[0]; v0[1] *= f[1]; v0[2] *= f[2]; v0[3] *= f[3]; v1[0] *= f[4]; v1[1] *= f[5]; v1[2] *= f[6]; v1[3] *= f[7];
                    acc[ai][bj][m][0] = v0; acc[ai][bj][m][1] = v1;
                    if (mode == 2) { u32x4 w; w.x = cvt_pk_bf16(v0[0], v0[1]); w.y = cvt_pk_bf16(v0[2], v0[3]); w.z = cvt_pk_bf16(v1[0], v1[1]); w.w = cvt_pk_bf16(v1[2], v1[3]);
                        *(u32x4*)(merged + (size_t)(row0 + ai * HALF + m * 16) * 4096 + col0 + bj * HALF) = w; } }
            asm volatile("" ::: "memory"); }
    }
};
struct EpiResF32 {
    static constexpr bool PERM = false, AFTER_DRAIN = false;
    const float* __restrict__ X; bf16_t* __restrict__ C; float* __restrict__ part; unsigned char* __restrict__ XN8;
    __device__ __forceinline__ void operator()(const f32x4 (&acc)[2][2][4][2], const Unit& u, int wr, int wc, int fr, int fq) const {
        const int row0 = u.pm * BM + wr * 64 + fr, col0 = u.pn * BM + wc * 32 + 4 * fq;
#pragma unroll
        for (int am = 0; am < 4; ++am) { const int ai = am >> 1;
            f32x4 xv[4][2][2];
#pragma unroll
            for (int m = 2 * (am & 1); m < 2 * (am & 1) + 2; ++m) { const size_t off = (size_t)(row0 + ai * HALF + m * 16) * 4096 + col0;
#pragma unroll
                for (int bj = 0; bj < 2; ++bj)
#pragma unroll
                    for (int n = 0; n < 2; ++n) xv[m][bj][n] = *(const f32x4*)(X + off + bj * HALF + n * 16); }
#pragma unroll
            for (int m = 2 * (am & 1); m < 2 * (am & 1) + 2; ++m) { const int row = row0 + ai * HALF + m * 16; const size_t off = (size_t)row * 4096 + col0; float ss = 0.f;
#pragma unroll
                for (int bj = 0; bj < 2; ++bj)
#pragma unroll
                    for (int n = 0; n < 2; ++n) { const f32x4 x1 = acc[ai][bj][m][n] + xv[m][bj][n];
                        typedef unsigned u32x2v __attribute__((ext_vector_type(2))); u32x2v w; w.x = cvt_pk_bf16(x1[0], x1[1]); w.y = cvt_pk_bf16(x1[2], x1[3]);
                        *(u32x2v*)(C + off + bj * HALF + n * 16) = w;
                        ss += (x1[0] * x1[0] + x1[1] * x1[1]) + (x1[2] * x1[2] + x1[3] * x1[3]);
                        int w8 = __builtin_amdgcn_cvt_pk_fp8_f32(x1[0], x1[1], 0, false); w8 = __builtin_amdgcn_cvt_pk_fp8_f32(x1[2], x1[3], w8, true); *(int*)(XN8 + off + bj * HALF + n * 16) = w8; }
                ss += __shfl_xor(ss, 16); ss += __shfl_xor(ss, 32);
                if (fq == 0) part[(size_t)row * 64 + u.pn * 4 + wc] = ss; }
        }
    }
};
struct EpiStoreBf16Rs {
    static constexpr bool PERM = true, AFTER_DRAIN = false;
    bf16_t* __restrict__ O; int ldc; const float* __restrict__ part;
    __device__ __forceinline__ void operator()(const f32x4 (&acc_in)[2][2][4][2], const Unit& u, int wr, int wc, int fr, int fq) const {
        f32x4 (&acc)[2][2][4][2] = const_cast<f32x4 (&)[2][2][4][2]>(acc_in);
#pragma unroll
        for (int ai = 0; ai < 2; ++ai) {
            f32x4 pv[4][4];
#pragma unroll
            for (int m = 0; m < 4; ++m) { const float* pp = part + (size_t)(u.pm * 256 + ai * HALF + wr * 64 + m * 16 + fr) * 64 + 16 * fq;
#pragma unroll
                for (int j = 0; j < 4; ++j) pv[m][j] = *(const f32x4*)(pp + 4 * j); }
#pragma unroll
            for (int m = 0; m < 4; ++m) { const f32x4 s4 = (pv[m][0] + pv[m][1]) + (pv[m][2] + pv[m][3]);
                float ss = (s4[0] + s4[1]) + (s4[2] + s4[3]); ss += __shfl_xor(ss, 16); ss += __shfl_xor(ss, 32);
                const float rs = rsqrtf(ss * (1.f / 4096.f) + 1e-6f);
#pragma unroll
                for (int bj = 0; bj < 2; ++bj)
#pragma unroll
                    for (int n = 0; n < 2; ++n) acc[ai][bj][m][n] = acc[ai][bj][m][n] * rs; }
        }
        store_tile_bf16(acc, O, ldc, u.pm * 256 + wr * 64 + fr, u.pn * 256 + wc * 32 + 8 * fq);
    }
};
template <class Epi, class Sched, bool ALIGN_EPI = false, bool SP2 = false>
__device__ __forceinline__ void gemm_phase(PG8_LAS unsigned char* lds, const Gemm g, const Sched& S, const Epi& E) {
    const int tid = threadIdx.x, wid = __builtin_amdgcn_readfirstlane(tid >> 6), lane = tid & 63, wr = wid >> 2, wc = wid & 3, fr = lane & 15, fq = lane >> 4;
    const int K = g.K;
    unsigned voffA[2], voffB[2];
#pragma unroll
    for (int i = 0; i < 2; ++i) { int R, C; stage_rc(tid * 16 + i * 8192, R, C); const int Rb = Epi::PERM ? ((R & ~31) + perm32(R & 31)) : R;
        voffA[i] = (unsigned)(R * K + C) * 2u; voffB[i] = (unsigned)(Rb * K + C) * 2u; }
    const size_t kstep = (size_t)(BK * 2);
    const size_t hstep = (size_t)HALF * K * 2;
    const size_t tstep = 2 * hstep;
    const unsigned ldsw = (unsigned)wid * 1024u;
    const int aoff = lds_byte(wr * 64 + fr, fq * 8), boff = lds_byte(wc * 32 + fr, fq * 8);
#define PG8_SA(b, h) (((b) * 2 + (h)) * HTB)
#define PG8_SB(b, h) ((4 + (b) * 2 + (h)) * HTB)
#define PG8_STAGE(bufoff, gbase, voff) do { _Pragma("unroll") for (int _i = 0; _i < 2; ++_i) \
        __builtin_amdgcn_global_load_lds((const unsigned*)((const char*)(gbase) + (voff)[_i]), (PG8_LAS unsigned*)(lds + (bufoff) + ldsw + _i * 8192), 16, 0, 0); } while (0)
#define PG8_LDA(dst, b, h) do { _Pragma("unroll") for (int m = 0; m < 4; ++m) _Pragma("unroll") for (int k = 0; k < 2; ++k) dst[m][k] = *(const PG8_LAS bf16x8*)(lds + PG8_SA(b, h) + aoff + m * 2048 + k * 1024); } while (0)
#define PG8_LDB(dst, b, h) do { _Pragma("unroll") for (int n = 0; n < 2; ++n) _Pragma("unroll") for (int k = 0; k < 2; ++k) dst[n][k] = *(const PG8_LAS bf16x8*)(lds + PG8_SB(b, h) + boff + n * 2048 + k * 1024); } while (0)
#define PG8_MMA(ai, bj, At, Bt) do { __builtin_amdgcn_s_setprio(1); _Pragma("unroll") for (int m = 0; m < 4; ++m) _Pragma("unroll") for (int n = 0; n < 2; ++n) _Pragma("unroll") for (int k = 0; k < 2; ++k) \
        acc[ai][bj][m][n] = __builtin_amdgcn_mfma_f32_16x16x32_bf16(Bt[n][k], At[m][k], acc[ai][bj][m][n], 0, 0, 0); __builtin_amdgcn_s_setprio(0); } while (0)
#define PG8_WAIT_V(n) asm volatile("s_waitcnt vmcnt(" #n ")" ::: "memory")
#define PG8_WAIT_L(n) asm volatile("s_waitcnt lgkmcnt(" #n ")" ::: "memory")
#define PG8_BAR __builtin_amdgcn_s_barrier()
#define PG8_SCHED __builtin_amdgcn_sched_barrier(0)
    Unit cur, nxt; int ui = 0;
    if (!S.next(0, cur)) return;
    f32x4 acc[2][2][4][2];
#pragma unroll
    for (int a = 0; a < 2; ++a)
#pragma unroll
        for (int b = 0; b < 2; ++b)
#pragma unroll
            for (int m = 0; m < 4; ++m)
#pragma unroll
                for (int n = 0; n < 2; ++n) acc[a][b][m][n] = (f32x4){0.f, 0.f, 0.f, 0.f};
    bf16x8 At[4][2], B0[2][2], B1[2][2];
    const char* cA = (const char*)g.A + (size_t)cur.pm * tstep + (size_t)cur.kt0 * (size_t)(BK * 2); const char* cB = (const char*)g.Bt + (size_t)cur.pn * tstep + (size_t)cur.kt0 * (size_t)(BK * 2);
    S.a_ready(cur);
    if constexpr (SP2) {
        PG8_STAGE(PG8_SB(0, 0), cB, voffB); PG8_STAGE(PG8_SB(0, 1), cB + hstep, voffB); PG8_STAGE(PG8_SA(0, 0), cA, voffA); PG8_STAGE(PG8_SA(0, 1), cA + hstep, voffA);
        if (wr == 1) PG8_BAR;
        PG8_WAIT_V(2); PG8_BAR;
        PG8_STAGE(PG8_SB(1, 0), cB + kstep, voffB); PG8_STAGE(PG8_SA(1, 0), cA + kstep, voffA); PG8_STAGE(PG8_SB(1, 1), cB + hstep + kstep, voffB);
        PG8_WAIT_V(6); PG8_BAR;
    } else {
        PG8_STAGE(PG8_SB(0, 0), cB, voffB); PG8_STAGE(PG8_SA(0, 0), cA, voffA); PG8_STAGE(PG8_SB(0, 1), cB + hstep, voffB); PG8_STAGE(PG8_SA(0, 1), cA + hstep, voffA);
        if (wr == 1) PG8_BAR;
        PG8_WAIT_V(4); PG8_BAR;
        PG8_STAGE(PG8_SB(1, 0), cB + kstep, voffB); PG8_STAGE(PG8_SA(1, 0), cA + kstep, voffA); PG8_STAGE(PG8_SB(1, 1), cB + hstep + kstep, voffB);
        PG8_WAIT_V(6); PG8_BAR;
    }
    for (;;) {
        const bool has_next = S.next(ui + 1, nxt);
        const char* nA = has_next ? (const char*)g.A + (size_t)nxt.pm * tstep + (size_t)nxt.kt0 * kstep : cA; const char* nB = has_next ? (const char*)g.Bt + (size_t)nxt.pn * tstep + (size_t)nxt.kt0 * kstep : cB;
        const int nt = cur.nkt;
        for (int t = 0; t < nt; t += 2) {
            const bool last = (t == nt - 2);
            const char* a1 = cA + (size_t)(t + 1) * kstep;
            const char* a2 = last ? nA : cA + (size_t)(t + 2) * kstep; const char* b2 = last ? nB : cB + (size_t)(t + 2) * kstep;
            const char* a3 = a2 + kstep; const char* b3 = b2 + kstep;
            if (last && has_next) S.a_ready(nxt);
            if constexpr (SP2) {
            PG8_LDB(B0, 0, 0); PG8_LDB(B1, 0, 1); PG8_SCHED; PG8_LDA(At, 0, 0); PG8_STAGE(PG8_SA(1, 1), a1 + hstep, voffA);
            PG8_WAIT_V(8); PG8_WAIT_L(0); PG8_BAR; PG8_MMA(0, 0, At, B0); PG8_MMA(0, 1, At, B1); PG8_BAR; PG8_SCHED;
            PG8_LDA(At, 0, 1); PG8_STAGE(PG8_SB(0, 0), b2, voffB); PG8_STAGE(PG8_SB(0, 1), b2 + hstep, voffB); PG8_STAGE(PG8_SA(0, 0), a2, voffA);
            PG8_WAIT_V(8); PG8_WAIT_L(0); PG8_BAR; PG8_MMA(1, 0, At, B0); PG8_MMA(1, 1, At, B1); PG8_BAR; PG8_SCHED;
            PG8_LDB(B0, 1, 0); PG8_LDB(B1, 1, 1); PG8_SCHED; PG8_LDA(At, 1, 0); PG8_STAGE(PG8_SA(0, 1), a2 + hstep, voffA);
            PG8_WAIT_V(8); PG8_WAIT_L(0); PG8_BAR; PG8_MMA(0, 0, At, B0); PG8_MMA(0, 1, At, B1); PG8_BAR; PG8_SCHED;
            PG8_LDA(At, 1, 1); PG8_STAGE(PG8_SB(1, 0), b3, voffB); PG8_STAGE(PG8_SB(1, 1), b3 + hstep, voffB); PG8_STAGE(PG8_SA(1, 0), a3, voffA);
            PG8_WAIT_V(8); PG8_WAIT_L(0); PG8_BAR; PG8_MMA(1, 0, At, B0); PG8_MMA(1, 1, At, B1); PG8_BAR; PG8_SCHED;
            } else {
            PG8_LDB(B0, 0, 0); PG8_SCHED; PG8_LDA(At, 0, 0); PG8_STAGE(PG8_SA(1, 1), a1 + hstep, voffA);
            PG8_WAIT_L(8); PG8_BAR; PG8_WAIT_L(0); PG8_MMA(0, 0, At, B0); PG8_BAR; PG8_SCHED;
            PG8_LDB(B1, 0, 1); PG8_STAGE(PG8_SB(0, 0), b2, voffB);
            PG8_BAR; PG8_WAIT_L(0); PG8_MMA(0, 1, At, B1); PG8_BAR;
            PG8_LDA(At, 0, 1); PG8_STAGE(PG8_SA(0, 0), a2, voffA);
            PG8_BAR; PG8_WAIT_L(0); PG8_MMA(1, 0, At, B0); PG8_BAR; PG8_SCHED;
            PG8_STAGE(PG8_SB(0, 1), b2 + hstep, voffB);
            PG8_WAIT_V(6); PG8_BAR; PG8_MMA(1, 1, At, B1); PG8_BAR;
            PG8_LDB(B0, 1, 0); PG8_SCHED; PG8_LDA(At, 1, 0); PG8_STAGE(PG8_SA(0, 1), a2 + hstep, voffA);
            PG8_WAIT_L(8); PG8_BAR; PG8_WAIT_L(0); PG8_MMA(0, 0, At, B0); PG8_BAR; PG8_SCHED;
            PG8_LDB(B1, 1, 1); PG8_STAGE(PG8_SB(1, 0), b3, voffB);
            PG8_BAR; PG8_WAIT_L(0); PG8_MMA(0, 1, At, B1); PG8_BAR;
            PG8_LDA(At, 1, 1); PG8_STAGE(PG8_SA(1, 0), a3, voffA);
            PG8_BAR; PG8_WAIT_L(0); PG8_MMA(1, 0, At, B0); PG8_BAR; PG8_SCHED;
            PG8_STAGE(PG8_SB(1, 1), b3 + hstep, voffB);
            PG8_WAIT_V(6); PG8_BAR; PG8_MMA(1, 1, At, B1); PG8_BAR;
            }
        }
        if constexpr (ALIGN_EPI) { if (wr == 0) PG8_BAR; }
        if constexpr (!Epi::AFTER_DRAIN) { E(acc, cur, wr, wc, fr, fq); S.done(cur); }
        if (!has_next) break;
        if (!cur.keep) {
#pragma unroll
        for (int a = 0; a < 2; ++a)
#pragma unroll
            for (int b = 0; b < 2; ++b)
#pragma unroll
                for (int m = 0; m < 4; ++m)
#pragma unroll
                    for (int n = 0; n < 2; ++n) acc[a][b][m][n] = (f32x4){0.f, 0.f, 0.f, 0.f};
        }
        cur = nxt; cA = nA; cB = nB; ++ui;
        if constexpr (ALIGN_EPI) { if (wr == 1) PG8_BAR; }
    }
    PG8_WAIT_V(0);
    if constexpr (!ALIGN_EPI) { if (wr == 0) PG8_BAR; }
    PG8_BAR;
    if constexpr (Epi::AFTER_DRAIN) { E.fused(acc, cur, wr, wc, fr, fq, lds, wid, lane); S.done(cur); }
#undef PG8_SA
#undef PG8_SB
#undef PG8_STAGE
#undef PG8_LDA
#undef PG8_LDB
#undef PG8_MMA
#undef PG8_WAIT_V
#undef PG8_WAIT_L
#undef PG8_BAR
#undef PG8_SCHED
}
typedef int i32x4 __attribute__((ext_vector_type(4)));
typedef int i32x8 __attribute__((ext_vector_type(8)));
template <class Epi, class Sched, bool ALIGN_EPI = false, bool SP2 = false>
__device__ __forceinline__ void gemm_phase_f8(PG8_LAS unsigned char* lds, const Gemm g, const Sched& S, const Epi& E) {
    const int tid = threadIdx.x, wid = __builtin_amdgcn_readfirstlane(tid >> 6), lane = tid & 63, wr = wid >> 2, wc = wid & 3, fr = lane & 15, fq = lane >> 4;
    const int K = g.K;
    unsigned voffA[2], voffB[2];
#pragma unroll
    for (int i = 0; i < 2; ++i) { int R, C; stage_rc(tid * 16 + i * 8192, R, C); const int Rb = Epi::PERM ? ((R & ~31) + perm32(R & 31)) : R;
        voffA[i] = (unsigned)(R * K + 2 * C); voffB[i] = (unsigned)(Rb * K + 2 * C); }
    const size_t kstep = (size_t)(BK * 2);
    const size_t hstep = (size_t)HALF * K;
    const size_t tstep = 2 * hstep;
    const unsigned ldsw = (unsigned)wid * 1024u;
    const int aoff = lds_byte(wr * 64 + fr, fq * 8), boff = lds_byte(wc * 32 + fr, fq * 8);
#define PG8_SA(b, h) (((b) * 2 + (h)) * HTB)
#define PG8_SB(b, h) ((4 + (b) * 2 + (h)) * HTB)
#define PG8_STAGE(bufoff, gbase, voff) do { _Pragma("unroll") for (int _i = 0; _i < 2; ++_i) \
        __builtin_amdgcn_global_load_lds((const unsigned*)((const char*)(gbase) + (voff)[_i]), (PG8_LAS unsigned*)(lds + (bufoff) + ldsw + _i * 8192), 16, 0, 0); } while (0)
#define PG8_LDA(dst, b, h) do { _Pragma("unroll") for (int m = 0; m < 4; ++m) { const i32x4 lo_ = *(const PG8_LAS i32x4*)(lds + PG8_SA(b, h) + aoff + m * 2048), hi_ = *(const PG8_LAS i32x4*)(lds + PG8_SA(b, h) + aoff + m * 2048 + 1024); dst[m] = __builtin_shufflevector(lo_, hi_, 0, 1, 2, 3, 4, 5, 6, 7); } } while (0)
#define PG8_LDB(dst, b, h) do { _Pragma("unroll") for (int n = 0; n < 2; ++n) { const i32x4 lo_ = *(const PG8_LAS i32x4*)(lds + PG8_SB(b, h) + boff + n * 2048), hi_ = *(const PG8_LAS i32x4*)(lds + PG8_SB(b, h) + boff + n * 2048 + 1024); dst[n] = __builtin_shufflevector(lo_, hi_, 0, 1, 2, 3, 4, 5, 6, 7); } } while (0)
#define PG8_MMA(ai, bj, At, Bt) do { __builtin_amdgcn_s_setprio(1); _Pragma("unroll") for (int m = 0; m < 4; ++m) _Pragma("unroll") for (int n = 0; n < 2; ++n) \
        asm volatile("v_mfma_scale_f32_16x16x128_f8f6f4 %0, %1, %2, %0, %3, %4 op_sel_hi:[0,0,0]" : "+v"(acc[ai][bj][m][n]) : "v"(Bt[n]), "v"(At[m]), "v"(sc_w), "v"(sc_1)); __builtin_amdgcn_s_setprio(0); } while (0)
#define PG8_WAIT_V(n) asm volatile("s_waitcnt vmcnt(" #n ")" ::: "memory")
#define PG8_WAIT_L(n) asm volatile("s_waitcnt lgkmcnt(" #n ")" ::: "memory")
#define PG8_BAR __builtin_amdgcn_s_barrier()
#define PG8_SCHED __builtin_amdgcn_sched_barrier(0)
    Unit cur, nxt; int ui = 0;
    if (!S.next(0, cur)) return;
    f32x4 acc[2][2][4][2];
#pragma unroll
    for (int a = 0; a < 2; ++a)
#pragma unroll
        for (int b = 0; b < 2; ++b)
#pragma unroll
            for (int m = 0; m < 4; ++m)
#pragma unroll
                for (int n = 0; n < 2; ++n) acc[a][b][m][n] = (f32x4){0.f, 0.f, 0.f, 0.f};
    i32x8 At[4], B0[2], B1[2];
    const int sc_w = 0x79797979, sc_1 = 0x7F7F7F7F;
    const char* cA = (const char*)g.A + (size_t)cur.pm * tstep + (size_t)cur.kt0 * (size_t)(BK * 2); const char* cB = (const char*)g.Bt + (size_t)cur.pn * tstep + (size_t)cur.kt0 * (size_t)(BK * 2);
    S.a_ready(cur);
    if constexpr (SP2) {
        PG8_STAGE(PG8_SB(0, 0), cB, voffB); PG8_STAGE(PG8_SB(0, 1), cB + hstep, voffB); PG8_STAGE(PG8_SA(0, 0), cA, voffA); PG8_STAGE(PG8_SA(0, 1), cA + hstep, voffA);
        if (wr == 1) PG8_BAR;
        PG8_WAIT_V(2); PG8_BAR;
        PG8_STAGE(PG8_SB(1, 0), cB + kstep, voffB); PG8_STAGE(PG8_SA(1, 0), cA + kstep, voffA); PG8_STAGE(PG8_SB(1, 1), cB + hstep + kstep, voffB);
        PG8_WAIT_V(6); PG8_BAR;
    } else {
        PG8_STAGE(PG8_SB(0, 0), cB, voffB); PG8_STAGE(PG8_SA(0, 0), cA, voffA); PG8_STAGE(PG8_SB(0, 1), cB + hstep, voffB); PG8_STAGE(PG8_SA(0, 1), cA + hstep, voffA);
        if (wr == 1) PG8_BAR;
        PG8_WAIT_V(4); PG8_BAR;
        PG8_STAGE(PG8_SB(1, 0), cB + kstep, voffB); PG8_STAGE(PG8_SA(1, 0), cA + kstep, voffA); PG8_STAGE(PG8_SB(1, 1), cB + hstep + kstep, voffB);
        PG8_WAIT_V(6); PG8_BAR;
    }
    for (;;) {
        const bool has_next = S.next(ui + 1, nxt);
        const char* nA = has_next ? (const char*)g.A + (size_t)nxt.pm * tstep + (size_t)nxt.kt0 * kstep : cA; const char* nB = has_next ? (const char*)g.Bt + (size_t)nxt.pn * tstep + (size_t)nxt.kt0 * kstep : cB;
        const int nt = cur.nkt;
        for (int t = 0; t < nt; t += 2) {
            const bool last = (t == nt - 2);
            const char* a1 = cA + (size_t)(t + 1) * kstep;
            const char* a2 = last ? nA : cA + (size_t)(t + 2) * kstep; const char* b2 = last ? nB : cB + (size_t)(t + 2) * kstep;
            const char* a3 = a2 + kstep; const char* b3 = b2 + kstep;
            if (last && has_next) S.a_ready(nxt);
            if constexpr (SP2) {
            PG8_LDB(B0, 0, 0); PG8_LDB(B1, 0, 1); PG8_SCHED; PG8_LDA(At, 0, 0); PG8_STAGE(PG8_SA(1, 1), a1 + hstep, voffA);
            PG8_WAIT_V(8); PG8_WAIT_L(0); PG8_BAR; PG8_MMA(0, 0, At, B0); PG8_MMA(0, 1, At, B1); PG8_BAR; PG8_SCHED;
            PG8_LDA(At, 0, 1); PG8_STAGE(PG8_SB(0, 0), b2, voffB); PG8_STAGE(PG8_SB(0, 1), b2 + hstep, voffB); PG8_STAGE(PG8_SA(0, 0), a2, voffA);
            PG8_WAIT_V(8); PG8_WAIT_L(0); PG8_BAR; PG8_MMA(1, 0, At, B0); PG8_MMA(1, 1, At, B1); PG8_BAR; PG8_SCHED;
            PG8_LDB(B0, 1, 0); PG8_LDB(B1, 1, 1); PG8_SCHED; PG8_LDA(At, 1, 0); PG8_STAGE(PG8_SA(0, 1), a2 + hstep, voffA);
            PG8_WAIT_V(8); PG8_WAIT_L(0); PG8_BAR; PG8_MMA(0, 0, At, B0); PG8_MMA(0, 1, At, B1); PG8_BAR; PG8_SCHED;
            PG8_LDA(At, 1, 1); PG8_STAGE(PG8_SB(1, 0), b3, voffB); PG8_STAGE(PG8_SB(1, 1), b3 + hstep, voffB); PG8_STAGE(PG8_SA(1, 0), a3, voffA);
            PG8_WAIT_V(8); PG8_WAIT_L(0); PG8_BAR; PG8_MMA(1, 0, At, B0); PG8_MMA(1, 1, At, B1); PG8_BAR; PG8_SCHED;
            } else {
            PG8_LDB(B0, 0, 0); PG8_SCHED; PG8_LDA(At, 0, 0); PG8_STAGE(PG8_SA(1, 1), a1 + hstep, voffA);
            PG8_WAIT_L(8); PG8_BAR; PG8_WAIT_L(0); PG8_MMA(0, 0, At, B0); PG8_BAR; PG8_SCHED;
            PG8_LDB(B1, 0, 1); PG8_STAGE(PG8_SB(0, 0), b2, voffB);
            PG8_BAR; PG8_WAIT_L(0); PG8_MMA(0, 1, At, B1); PG8_BAR;
            PG8_LDA(At, 0, 1); PG8_STAGE(PG8_SA(0, 0), a2, voffA);
            PG8_BAR; PG8_WAIT_L(0); PG8_MMA(1, 0, At, B0); PG8_BAR; PG8_SCHED;
            PG8_STAGE(PG8_SB(0, 1), b2 + hstep, voffB);
            PG8_WAIT_V(6); PG8_BAR; PG8_MMA(1, 1, At, B1); PG8_BAR;
            PG8_LDB(B0, 1, 0); PG8_SCHED; PG8_LDA(At, 1, 0); PG8_STAGE(PG8_SA(0, 1), a2 + hstep, voffA);
            PG8_WAIT_L(8); PG8_BAR; PG8_WAIT_L(0); PG8_MMA(0, 0, At, B0); PG8_BAR; PG8_SCHED;
            PG8_LDB(B1, 1, 1); PG8_STAGE(PG8_SB(1, 0), b3, voffB);
            PG8_BAR; PG8_WAIT_L(0); PG8_MMA(0, 1, At, B1); PG8_BAR;
            PG8_LDA(At, 1, 1); PG8_STAGE(PG8_SA(1, 0), a3, voffA);
            PG8_BAR; PG8_WAIT_L(0); PG8_MMA(1, 0, At, B0); PG8_BAR; PG8_SCHED;
            PG8_STAGE(PG8_SB(1, 1), b3 + hstep, voffB);
            PG8_WAIT_V(6); PG8_BAR; PG8_MMA(1, 1, At, B1); PG8_BAR;
            }
        }
        if constexpr (ALIGN_EPI) { if (wr == 0) PG8_BAR; }
        asm volatile("s_nop 15\n\ts_nop 15\n\ts_nop 15" ::: "memory");
        if constexpr (!Epi::AFTER_DRAIN) { E(acc, cur, wr, wc, fr, fq); S.done(cur); }
        if (!has_next) break;
        if (!cur.keep) {
#pragma unroll
        for (int a = 0; a < 2; ++a)
#pragma unroll
            for (int b = 0; b < 2; ++b)
#pragma unroll
                for (int m = 0; m < 4; ++m)
#pragma unroll
                    for (int n = 0; n < 2; ++n) acc[a][b][m][n] = (f32x4){0.f, 0.f, 0.f, 0.f};
        }
        cur = nxt; cA = nA; cB = nB; ++ui;
        if constexpr (ALIGN_EPI) { if (wr == 1) PG8_BAR; }
    }
    PG8_WAIT_V(0);
    if constexpr (!ALIGN_EPI) { if (wr == 0) PG8_BAR; }
    PG8_BAR;
    if constexpr (Epi::AFTER_DRAIN) { E.fused(acc, cur, wr, wc, fr, fq, lds, wid, lane); S.done(cur); }
#undef PG8_SA
#undef PG8_SB
#undef PG8_STAGE
#undef PG8_LDA
#undef PG8_LDB
#undef PG8_MMA
#undef PG8_WAIT_V
#undef PG8_WAIT_L
#undef PG8_BAR
#undef PG8_SCHED
}
}

constexpr int NB = 2, SEQ = 4096, DM = 4096, NT = NB * SEQ;
constexpr int MEML = 256, NMEM = NB * MEML;
constexpr int LDP = 22016;
constexpr int C_RQ = 0, C_RK = 1024, C_RV = 2048, C_RG = 4096, C_AQ = 6144, C_AK = 7168, C_AV = 7296, C_IQ = 7424, C_IK = 8448, C_IW = 8512, C_MQ = 8528, C_GT = 9552, NPROJ = 21840;
constexpr float EPS = 1e-6f;
constexpr int CONV_R0 = 16384;
constexpr int NWAVES = 8, NTHR = 512;
#ifndef MK_PER_PHASE
#define MK_PER_PHASE 0
#endif
constexpr int NPH = 11;

constexpr size_t MiB = 1u << 20;
constexpr size_t WS_CTL = 0, CTL_ZERO_BYTES = 1 * MiB;
constexpr size_t WS_R = 1 * MiB;
constexpr size_t WS_R8 = WS_R;
constexpr size_t WS_SCORES = WS_R;
constexpr size_t WS_X1B = WS_R;
constexpr size_t WS_SG = 129 * MiB;
constexpr size_t WS_PROJ = 257 * MiB;
constexpr size_t WS_XN2 = WS_PROJ;
constexpr size_t WS_QP = WS_PROJ + 64 * MiB;
constexpr size_t WS_EIDX = WS_PROJ + 96 * MiB;
constexpr size_t WS_EGATE = WS_PROJ + 100 * MiB;
constexpr size_t WS_XN8 = WS_PROJ + 104 * MiB;
constexpr size_t WS_WUP = 601 * MiB, WS_WOUT = 633 * MiB, WS_WQ = 665 * MiB;
constexpr size_t WS_MK = 681 * MiB, WS_MVT = 682 * MiB, WS_MKN = 683 * MiB, WS_SKB = 684 * MiB;
constexpr size_t WS_AQN = 685 * MiB, WS_AKN = 701 * MiB, WS_AVC = 703 * MiB, WS_MQN = 705 * MiB;
constexpr size_t WS_SC = 721 * MiB;
constexpr size_t WS_ST = 785 * MiB;
constexpr size_t WS_IDX = 817 * MiB;
constexpr size_t WS_Y = 821 * MiB;
constexpr size_t WS_MERGED = 885 * MiB;
constexpr size_t WS_U8 = 949 * MiB, WS_V8 = 1013 * MiB;
constexpr int XROW = 2176;
constexpr int XSL = 272;
constexpr size_t XSLICE = (size_t)16384 * XSL;
constexpr size_t WS_END = 1077 * MiB;
constexpr size_t WS_PART = 1050 * MiB;
constexpr int CW_BAR = 4096;

constexpr int LDS_SCR = 155648;
constexpr int LDSCTL_OFF = LDS_SCR;
constexpr int LDS_BYTES = LDS_SCR + 256;

#define GAS __attribute__((address_space(1)))
#define LAS __attribute__((address_space(3)))
typedef unsigned short bf16;
typedef unsigned v4u __attribute__((ext_vector_type(4)));
typedef unsigned v2u __attribute__((ext_vector_type(2)));
typedef short s16x4 __attribute__((ext_vector_type(4)));
using pg8::f32x4; using pg8::bf16x8;
#define LDS_WAIT() asm volatile("s_waitcnt lgkmcnt(0)" ::: "memory")
__device__ __forceinline__ float bflo(unsigned w) { return __uint_as_float(w << 16); }
__device__ __forceinline__ float bfhi(unsigned w) { return __uint_as_float(w & 0xffff0000u); }
__device__ __forceinline__ unsigned f2bf(float f) { unsigned u = __float_as_uint(f); return (u + 0x7fffu + ((u >> 16) & 1u)) >> 16; }
__device__ __forceinline__ unsigned pk2(float lo, float hi) { return f2bf(lo) | (f2bf(hi) << 16); }
__device__ __forceinline__ float wave_sum(float v) {
#pragma unroll
    for (int o = 1; o < 64; o <<= 1) v += __shfl_xor(v, o);
    return v;
}
__device__ __forceinline__ int wave_sum_i(int v) {
#pragma unroll
    for (int o = 1; o < 64; o <<= 1) v += __shfl_xor(v, o);
    return v;
}
template <int CTRL> __device__ __forceinline__ float dpp_f(float v) { return __int_as_float(__builtin_amdgcn_update_dpp(0, __float_as_int(v), CTRL, 0xF, 0xF, true)); }
__device__ __forceinline__ float wave_sum_dpp(float v) {
    v += dpp_f<0xB1>(v); v += dpp_f<0x4E>(v); v += dpp_f<0x141>(v); v += dpp_f<0x140>(v);
    const int iv = __float_as_int(v);
    return (__int_as_float(__builtin_amdgcn_readlane(iv, 0)) + __int_as_float(__builtin_amdgcn_readlane(iv, 16))) + (__int_as_float(__builtin_amdgcn_readlane(iv, 32)) + __int_as_float(__builtin_amdgcn_readlane(iv, 48)));
}
__device__ __forceinline__ f32x4 mfma16(bf16x8 a, bf16x8 b, f32x4 c) { return __builtin_amdgcn_mfma_f32_16x16x32_bf16(a, b, c, 0, 0, 0); }
__device__ __forceinline__ unsigned lds_addr(const LAS unsigned char* p) { return (unsigned)(size_t)p; }
__device__ __forceinline__ bf16x8 tr_read8(unsigned a0, unsigned a1) {
    s16x4 lo, hi;
    asm volatile("ds_read_b64_tr_b16 %0, %2\n\tds_read_b64_tr_b16 %1, %3\n\ts_waitcnt lgkmcnt(0)" : "=&v"(lo), "=&v"(hi) : "v"(a0), "v"(a1) : "memory");
    bf16x8 r; r[0] = lo[0]; r[1] = lo[1]; r[2] = lo[2]; r[3] = lo[3]; r[4] = hi[0]; r[5] = hi[1]; r[6] = hi[2]; r[7] = hi[3]; return r;
}
__device__ __forceinline__ void tr_read8x4(unsigned a0, unsigned a1, bf16x8 (&f)[4]) {
    s16x4 l0, h0, l1, h1, l2, h2, l3, h3;
    asm volatile("ds_read_b64_tr_b16 %0, %8\n\tds_read_b64_tr_b16 %1, %9\n\tds_read_b64_tr_b16 %2, %8 offset:32\n\tds_read_b64_tr_b16 %3, %9 offset:32\n\t"
                 "ds_read_b64_tr_b16 %4, %8 offset:64\n\tds_read_b64_tr_b16 %5, %9 offset:64\n\tds_read_b64_tr_b16 %6, %8 offset:96\n\tds_read_b64_tr_b16 %7, %9 offset:96\n\ts_waitcnt lgkmcnt(0)"
                 : "=&v"(l0), "=&v"(h0), "=&v"(l1), "=&v"(h1), "=&v"(l2), "=&v"(h2), "=&v"(l3), "=&v"(h3) : "v"(a0), "v"(a1) : "memory");
    f[0] = (bf16x8){l0[0], l0[1], l0[2], l0[3], h0[0], h0[1], h0[2], h0[3]}; f[1] = (bf16x8){l1[0], l1[1], l1[2], l1[3], h1[0], h1[1], h1[2], h1[3]};
    f[2] = (bf16x8){l2[0], l2[1], l2[2], l2[3], h2[0], h2[1], h2[2], h2[3]}; f[3] = (bf16x8){l3[0], l3[1], l3[2], l3[3], h3[0], h3[1], h3[2], h3[3]};
}

#define XB_TMO      128
#define XB_XCNT(j)  (256  + 64 * (j))
#define XB_XSUB(j)  (1280 + 64 * (j))
#define XB_XGEN(j)  (2304 + 64 * (j))
#define XB_TOP      3328
#define XB_TOPGEN   3392
#define XCD_BAR_WORDS 3456
#define XB_SPIN_CAP (1u << 22)

__device__ __forceinline__ unsigned xb_ld(unsigned* p)              { return __hip_atomic_load(p, __ATOMIC_RELAXED, __HIP_MEMORY_SCOPE_AGENT); }
__device__ __forceinline__ unsigned xb_add(unsigned* p, unsigned v) { return __hip_atomic_fetch_add(p, v, __ATOMIC_RELAXED, __HIP_MEMORY_SCOPE_AGENT); }
__device__ __forceinline__ unsigned xb_xcc_id() { return (unsigned)__builtin_amdgcn_s_getreg((3 << 11) | 20) & 0xFu; }
#define XB_SPIN(cond, bar) do { unsigned _sp = 0; while (cond) { __builtin_amdgcn_s_sleep(1); \
    if ((++_sp & 255u) == 0u) { if (xb_ld(&(bar)[XB_TMO])) break; if (_sp > XB_SPIN_CAP) { atomicAdd(&(bar)[XB_TMO], 1u); break; } } } } while (0)

struct XcdBarrier {
    unsigned* bar; unsigned x;
    volatile LAS unsigned* st;
};

__device__ __forceinline__ XcdBarrier xcd_barrier_post(unsigned* bar, volatile LAS unsigned* st) {
    XcdBarrier b; b.bar = bar; b.x = xb_xcc_id(); b.st = st;
    if (threadIdx.x == 0) (void)xb_add(&bar[XB_XCNT(b.x)], 1u);
    return b;
}
__device__ __forceinline__ void xcd_barrier_complete(unsigned* bar, unsigned x, unsigned& nloc, unsigned& nx) {
    const unsigned G = gridDim.x * gridDim.y * gridDim.z;
    unsigned sum, cnt, mine, sp = 0u;
    for (;;) {
        sum = 0u; cnt = 0u; mine = 0u;
#pragma unroll
        for (unsigned j = 0; j < 16; ++j) { const unsigned c = xb_ld(&bar[XB_XCNT(j)]); sum += c; cnt += (c > 0u) ? 1u : 0u; mine = (j == x) ? c : mine; }
        if (sum == G) break;
        __builtin_amdgcn_s_sleep(1);
        if ((++sp & 255u) == 0u) { if (xb_ld(&bar[XB_TMO])) break; if (sp > XB_SPIN_CAP) { atomicAdd(&bar[XB_TMO], 1u); break; } }
    }
    nloc = mine > 0u ? mine : 1u; nx = cnt > 0u ? cnt : 1u;
}

__device__ __forceinline__ void xcd_barrier(const XcdBarrier& b) {
    asm volatile("s_waitcnt vmcnt(0)" ::: "memory");
    __syncthreads();
    if (threadIdx.x == 0) {
        unsigned* bar = b.bar;
        __builtin_amdgcn_s_waitcnt(0);
        unsigned nloc = b.st[0], nx = b.st[1];
        if (nloc == 0u) { xcd_barrier_complete(bar, b.x, nloc, nx); b.st[0] = nloc; b.st[1] = nx; }
        const unsigned old = xb_add(&bar[XB_XSUB(b.x)], 1u);
        const unsigned gen = old / nloc;
        if (old + 1u == (gen + 1u) * nloc) {
            __builtin_amdgcn_fence(__ATOMIC_RELEASE, "agent");
            asm volatile("s_waitcnt vmcnt(0)" ::: "memory");
            const unsigned og = xb_add(&bar[XB_TOP], 1u);
            const unsigned tg = og / nx;
            if (og + 1u == (tg + 1u) * nx) xb_add(&bar[XB_TOPGEN], 1u);
            else XB_SPIN(xb_ld(&bar[XB_TOPGEN]) == tg, bar);
            __builtin_amdgcn_fence(__ATOMIC_ACQUIRE, "agent");
            xb_add(&bar[XB_XGEN(b.x)], 1u);
            asm volatile("s_waitcnt vmcnt(0)" ::: "memory");
        } else {
            XB_SPIN(xb_ld(&bar[XB_XGEN(b.x)]) == gen, bar);
            __builtin_amdgcn_fence(__ATOMIC_ACQUIRE, "agent");
            asm volatile("s_waitcnt vmcnt(0)" ::: "memory");
        }
    }
    __syncthreads();
}


struct Params {
    const float *x, *mem; const int* pos;
    const float *ln1_g, *w_in, *att_q_g, *att_k_g, *rel_bias, *mem_g, *w_mem_kv, *mem_q_g, *mem_k_g, *w_up_ret, *w_up_att, *w_up_mem, *w_out, *ln2_g, *peer_w_q, *peer_sub_keys, *peer_u, *peer_v;
    float* out; unsigned char* ws;
    int ph_lo, ph_hi, li, pad;
};
#define WSP(T, off) ((T*)(p.ws + (off)))

__device__ __forceinline__ void transpose_item(const float* W, int N, bf16* WT, int dstK, int row_off, int col_off, int nblk, LAS float* scr, int item, int lane, int ldw = 0, const float* kscale = nullptr) {
    if (ldw == 0) ldw = N;
    const int kb = item / nblk, nb = item - kb * nblk, k0 = 64 * kb, n0 = 64 * nb;
    const int c4 = lane & 15, kr = lane >> 4; const bool ok = (n0 + 4 * c4) < N;
    f32x4 v[16];
#pragma unroll
    for (int i = 0; i < 16; ++i) v[i] = ok ? *(const f32x4*)(W + (size_t)(k0 + 4 * i + kr) * ldw + n0 + 4 * c4) : (f32x4){0.f, 0.f, 0.f, 0.f};
    if (kscale) {
        float ks[16];
#pragma unroll
        for (int i = 0; i < 16; ++i) ks[i] = kscale[k0 + 4 * i + kr];
#pragma unroll
        for (int i = 0; i < 16; ++i) v[i] = v[i] * ks[i];
    }
#pragma unroll
    for (int i = 0; i < 16; ++i) { LAS float* d = scr + (4 * i + kr) * 65 + 4 * c4; d[0] = v[i].x; d[1] = v[i].y; d[2] = v[i].z; d[3] = v[i].w; }
    LDS_WAIT(); asm volatile("" ::: "memory");
    const int c = lane & 7;
#pragma unroll
    for (int j = 0; j < 8; ++j) { const int n = (lane >> 3) + 8 * j; const LAS float* s = scr + (8 * c) * 65 + n;
        v4u o; o.x = pk2(s[0 * 65], s[1 * 65]); o.y = pk2(s[2 * 65], s[3 * 65]); o.z = pk2(s[4 * 65], s[5 * 65]); o.w = pk2(s[6 * 65], s[7 * 65]);
        *(v4u*)(WT + (size_t)(row_off + n0 + n) * dstK + col_off + k0 + 8 * c) = o; }
    LDS_WAIT(); asm volatile("" ::: "memory");
}
__device__ __forceinline__ unsigned pack_fp8x4(f32x4 v, float sc) {
    int w = 0;
    w = __builtin_amdgcn_cvt_pk_fp8_f32(__builtin_amdgcn_fmed3f(v.x * sc, -448.f, 448.f), __builtin_amdgcn_fmed3f(v.y * sc, -448.f, 448.f), w, false);
    w = __builtin_amdgcn_cvt_pk_fp8_f32(__builtin_amdgcn_fmed3f(v.z * sc, -448.f, 448.f), __builtin_amdgcn_fmed3f(v.w * sc, -448.f, 448.f), w, true);
    return (unsigned)w;
}
__device__ __forceinline__ void transpose_item_f8(const float* W, int ldw, int col0, int N, unsigned char* W8, int row_off, int nblk, LAS float* scr, int item, int lane) {
    const int pi = item >> 1, kb2 = pi / nblk, nb = pi - kb2 * nblk, kb = 2 * kb2 + (item & 1), k0 = 64 * kb, n0 = 64 * nb;
    const int c4 = lane & 15, kr = lane >> 4; const bool ok = (n0 + 4 * c4) < N;
    f32x4 v[16];
#pragma unroll
    for (int i = 0; i < 16; ++i) v[i] = ok ? *(const f32x4*)(W + (size_t)(k0 + 4 * i + kr) * ldw + col0 + n0 + 4 * c4) : (f32x4){0.f, 0.f, 0.f, 0.f};
#pragma unroll
    for (int i = 0; i < 16; ++i) { LAS float* d = scr + (4 * i + kr) * 65 + 4 * c4; d[0] = v[i].x; d[1] = v[i].y; d[2] = v[i].z; d[3] = v[i].w; }
    LDS_WAIT(); asm volatile("" ::: "memory");
    const int c = lane & 7;
#pragma unroll
    for (int j = 0; j < 8; ++j) { const int n = (lane >> 3) + 8 * j; const LAS float* s = scr + (8 * c) * 65 + n;
        v2u o; o.x = pack_fp8x4((f32x4){s[0 * 65], s[1 * 65], s[2 * 65], s[3 * 65]}, 64.f); o.y = pack_fp8x4((f32x4){s[4 * 65], s[5 * 65], s[6 * 65], s[7 * 65]}, 64.f);
        *(v2u*)(W8 + (size_t)(row_off + n0 + n) * 4096 + k0 + 8 * c) = o; }
    LDS_WAIT(); asm volatile("" ::: "memory");
}
template <bool BF> __device__ __forceinline__ void rms_row_to_both(const float* xrow, const float* gain, bf16* orow, unsigned char* orow8, int lane) {
    const f32x4* xr = (const f32x4*)xrow + lane; const f32x4* gr = (const f32x4*)gain + lane;
    f32x4 v[16]; float s = 0.f;
#pragma unroll
    for (int j = 0; j < 16; ++j) { v[j] = xr[64 * j]; s += (v[j].x * v[j].x + v[j].y * v[j].y) + (v[j].z * v[j].z + v[j].w * v[j].w); }
    const float r = rsqrtf(wave_sum(s) * (1.f / 4096.f) + EPS);
    v2u* o8 = (v2u*)orow + lane; unsigned* o4 = (unsigned*)orow8 + lane;
#pragma unroll
    for (int j = 0; j < 16; ++j) { const f32x4 g = gr[64 * j]; const f32x4 y = (f32x4){v[j].x * r * g.x, v[j].y * r * g.y, v[j].z * r * g.z, v[j].w * r * g.w};
        if (BF) { v2u o; o.x = pk2(y.x, y.y); o.y = pk2(y.z, y.w); o8[64 * j] = o; } o4[64 * j] = pack_fp8x4(y, 1.f); }
}
__device__ __forceinline__ void rms_row_to_bf16(const float* xrow, const float* gain, bf16* orow, int lane) {
    const f32x4* xr = (const f32x4*)xrow + lane; const f32x4* gr = (const f32x4*)gain + lane;
    f32x4 v[16]; float s = 0.f;
#pragma unroll
    for (int j = 0; j < 16; ++j) { v[j] = xr[64 * j]; s += (v[j].x * v[j].x + v[j].y * v[j].y) + (v[j].z * v[j].z + v[j].w * v[j].w); }
    const float r = rsqrtf(wave_sum(s) * (1.f / 4096.f) + EPS);
    v2u* o8 = (v2u*)orow + lane;
#pragma unroll
    for (int j = 0; j < 16; ++j) { const f32x4 g = gr[64 * j]; v2u o; o.x = pk2(v[j].x * r * g.x, v[j].y * r * g.y); o.y = pk2(v[j].z * r * g.z, v[j].w * r * g.w); o8[64 * j] = o; }
}
__device__ __forceinline__ void phase0(const Params& p, LAS unsigned char* lds, int tid, int wave, int lane) {
    LAS float* scr = (LAS float*)(lds + wave * 16640);
    const int gw = blockIdx.x * NWAVES + wave, NGW = gridDim.x * NWAVES;
    bf16* R = WSP(bf16, WS_R); unsigned char* R8 = WSP(unsigned char, WS_R8);
    constexpr int I_IN = 0, I_GT = 64 * 344, I_KV = 64 * 32, I_UR = 32 * 64, I_UA = 16 * 64, I_UM = 16 * 64, I_WO = 64 * 64, I_WQ = 64 * 32;
    constexpr int NITEMS = I_IN + I_GT + I_KV + I_UR + I_UA + I_UM + I_WO + I_WQ;
#ifndef SUBREP
#define SUBREP 0
#endif
    for (int it0 = gw; it0 < ((SUBREP & 32) ? 2 : 1) * NITEMS; it0 += NGW) {
        const int it = it0 >= NITEMS ? it0 - NITEMS : it0; int r = it;
        if (r < I_IN) { transpose_item(p.w_in, 6144, R, 4096, 8192, 0, 96, scr, r, lane, NPROJ); continue; } r -= I_IN;
        if (r < I_GT) { transpose_item_f8(p.w_in, NPROJ, 0, NPROJ, R8, 8704, 344, scr, r, lane); continue; } r -= I_GT;
        if (r < I_KV) { transpose_item_f8(p.w_mem_kv, 2048, 0, 2048, R8, 30720, 32, scr, r, lane); continue; } r -= I_KV;
        if (r < I_UR) { transpose_item(p.w_up_ret, 4096, WSP(bf16, WS_WUP), 4096, 0, 0, 64, scr, r, lane); continue; } r -= I_UR;
        if (r < I_UA) { transpose_item(p.w_up_att, 4096, WSP(bf16, WS_WUP), 4096, 0, 2048, 64, scr, r, lane); continue; } r -= I_UA;
        if (r < I_UM) { transpose_item(p.w_up_mem, 4096, WSP(bf16, WS_WUP), 4096, 0, 3072, 64, scr, r, lane); continue; } r -= I_UM;
        if (r < I_WO) { transpose_item(p.w_out, 4096, WSP(bf16, WS_WOUT), 4096, 0, 0, 64, scr, r, lane); continue; } r -= I_WO;
        transpose_item(p.peer_w_q, 2048, WSP(bf16, WS_WQ), 4096, 0, 0, 32, scr, r, lane, 0, p.ln2_g);
    }
    for (int m0 = gw; m0 < ((SUBREP & 64) ? 2 : 1) * NT; m0 += NGW) { const int m = m0 & (NT - 1); rms_row_to_both<false>(p.x + (size_t)m * DM, p.ln1_g, nullptr, R8 + (size_t)m * DM, lane); }
    for (int m = gw; m < NMEM; m += NGW) rms_row_to_both<false>(p.mem + (size_t)m * DM, p.mem_g, nullptr, R8 + (size_t)(NT + m) * DM, lane);
    {
        constexpr size_t NOCT = (size_t)16384 * 4096 / 8;
        const size_t stride = (size_t)gridDim.x * NTHR;
        for (size_t o0 = (size_t)blockIdx.x * NTHR + tid; o0 < (size_t)CONV_R0 * 512; o0 += 4 * stride) {
            f32x4 av[4], cv[4];
#pragma unroll
            for (int u = 0; u < 4; ++u) { size_t o = o0 + u * stride; o = o < (size_t)CONV_R0 * 512 ? o : o0; const bool isv = o >= NOCT; const size_t oo = isv ? o - NOCT : o;
                const float* __restrict__ src = (isv ? p.peer_v : p.peer_u) + oo * 8; av[u] = *(const f32x4*)src; cv[u] = *(const f32x4*)(src + 4); }
#pragma unroll
            for (int u = 0; u < 4; ++u) { const size_t o = o0 + u * stride; if (o >= (size_t)CONV_R0 * 512) break;
                const bool isv = o >= NOCT; const size_t oo = isv ? o - NOCT : o; unsigned char* dst = WSP(unsigned char, isv ? WS_V8 : WS_U8);
                f32x4 a = av[u], c = cv[u];
                if (!isv) { const float* g2 = p.ln2_g + (int)(oo & 511) * 8; a = a * *(const f32x4*)g2; c = c * *(const f32x4*)(g2 + 4); }
                float mx = fmaxf(fmaxf(fmaxf(fabsf(a.x), fabsf(a.y)), fmaxf(fabsf(a.z), fabsf(a.w))), fmaxf(fmaxf(fabsf(c.x), fabsf(c.y)), fmaxf(fabsf(c.z), fabsf(c.w))));
                mx = fmaxf(mx, __shfl_xor(mx, 1)); mx = fmaxf(mx, __shfl_xor(mx, 2));
                int ex = (int)ceilf(log2f(fmaxf(mx, 1e-30f) * (1.f / 6.f))); ex = ex < -120 ? -120 : (ex > 120 ? 120 : ex);
                const float inv = __uint_as_float((unsigned)(127 - ex) << 23);
                unsigned w = 0;
                w = __builtin_amdgcn_cvt_scalef32_pk_fp4_f32(w, a.x * inv, a.y * inv, 1.0f, 0); w = __builtin_amdgcn_cvt_scalef32_pk_fp4_f32(w, a.z * inv, a.w * inv, 1.0f, 1);
                w = __builtin_amdgcn_cvt_scalef32_pk_fp4_f32(w, c.x * inv, c.y * inv, 1.0f, 2); w = __builtin_amdgcn_cvt_scalef32_pk_fp4_f32(w, c.z * inv, c.w * inv, 1.0f, 3);
                const size_t row = oo >> 9; const int g8 = (int)(oo & 511);
                unsigned char* q = dst + (size_t)(g8 >> 6) * XSLICE + row * XSL;
                *(unsigned*)(q + 4 * (g8 & 63)) = w;
                if ((g8 & 3) == 0) q[256 + ((g8 & 63) >> 2)] = (unsigned char)(127 + ex);
            }
        }
    }
    bf16* skb = WSP(bf16, WS_SKB);
    for (int i = (blockIdx.x * NTHR + tid) * 4; i < 8 * 2 * 128 * 128; i += gridDim.x * NTHR * 4) { const f32x4 v = *(const f32x4*)(p.peer_sub_keys + i); v2u o; o.x = pk2(v.x, v.y); o.y = pk2(v.z, v.w); *(v2u*)(skb + i) = o; }
}

struct ConvRow { f32x4 a[8], c[8]; };
__device__ __forceinline__ void conv_row_load(const Params& p, int r, int lane, ConvRow& x) {
    const float* src0 = (r >= 16384 ? p.peer_v : p.peer_u) + (size_t)(r & 16383) * 4096;
#pragma unroll
    for (int u = 0; u < 8; ++u) { const float* src = src0 + (size_t)(64 * u + lane) * 8; x.a[u] = *(const f32x4*)src; x.c[u] = *(const f32x4*)(src + 4); }
}
__device__ __forceinline__ void conv_row_store(const Params& p, int r, int lane, const ConvRow& x) {
    const bool isv = r >= 16384; unsigned char* dst = WSP(unsigned char, isv ? WS_V8 : WS_U8); const int row = r & 16383;
#pragma unroll
    for (int u = 0; u < 8; ++u) {
        f32x4 a = x.a[u], c = x.c[u];
        if (!isv) { const float* g2 = p.ln2_g + (64 * u + lane) * 8; a = a * *(const f32x4*)g2; c = c * *(const f32x4*)(g2 + 4); }
        float mx = fmaxf(fmaxf(fmaxf(fabsf(a.x), fabsf(a.y)), fmaxf(fabsf(a.z), fabsf(a.w))), fmaxf(fmaxf(fabsf(c.x), fabsf(c.y)), fmaxf(fabsf(c.z), fabsf(c.w))));
        mx = fmaxf(mx, __shfl_xor(mx, 1)); mx = fmaxf(mx, __shfl_xor(mx, 2));
        int ex = (int)ceilf(log2f(fmaxf(mx, 1e-30f) * (1.f / 6.f))); ex = ex < -120 ? -120 : (ex > 120 ? 120 : ex);
        const float inv = __uint_as_float((unsigned)(127 - ex) << 23);
        unsigned w = 0;
        w = __builtin_amdgcn_cvt_scalef32_pk_fp4_f32(w, a.x * inv, a.y * inv, 1.0f, 0); w = __builtin_amdgcn_cvt_scalef32_pk_fp4_f32(w, a.z * inv, a.w * inv, 1.0f, 1);
        w = __builtin_amdgcn_cvt_scalef32_pk_fp4_f32(w, c.x * inv, c.y * inv, 1.0f, 2); w = __builtin_amdgcn_cvt_scalef32_pk_fp4_f32(w, c.z * inv, c.w * inv, 1.0f, 3);
        unsigned char* q = dst + (size_t)u * XSLICE + (size_t)row * XSL;
        *(unsigned*)(q + 4 * lane) = w;
        if ((lane & 3) == 0) q[256 + (lane >> 2)] = (unsigned char)(127 + ex);
    }
}
__device__ __forceinline__ void convert_rows_wave(const Params& p, int cw, int ncw, int lane) {
    const int nrows = 32768 - CONV_R0, per = (nrows / ncw) & ~1, beg = CONV_R0 + cw * per, end = (cw == ncw - 1) ? 32768 : beg + per;
    if (beg >= end) return;
    ConvRow A, B;
    conv_row_load(p, beg, lane, A);
#pragma unroll 1
    for (int r = beg; r < end; r += 2) {
        conv_row_load(p, r + 1, lane, B);
        conv_row_store(p, r, lane, A);
        if (r + 2 < end) conv_row_load(p, r + 2, lane, A);
        conv_row_store(p, r + 1, lane, B);
    }
}

__device__ __forceinline__ void unpack16(const bf16* src, float (&x)[16]) {
    const v4u a = *(const v4u*)src, b = *(const v4u*)(src + 8);
#pragma unroll
    for (int e = 0; e < 4; ++e) { x[2 * e] = bflo(a[e]); x[2 * e + 1] = bfhi(a[e]); x[8 + 2 * e] = bflo(b[e]); x[8 + 2 * e + 1] = bfhi(b[e]); }
}
__device__ __forceinline__ void pack16(bf16* dst, const float (&x)[16]) {
    v4u a, b;
#pragma unroll
    for (int e = 0; e < 4; ++e) { a[e] = pk2(x[2 * e], x[2 * e + 1]); b[e] = pk2(x[8 + 2 * e], x[8 + 2 * e + 1]); }
    *(v4u*)dst = a; *(v4u*)(dst + 8) = b;
}
__device__ __forceinline__ void norm_token(const Params& p, int bt, int lane) {
    const bf16* pr = WSP(const bf16, WS_PROJ) + (size_t)bt * LDP;
    { float x[16]; unpack16(pr + C_AQ + 16 * lane, x); float ss = 0.f;
#pragma unroll
      for (int i = 0; i < 16; ++i) ss += x[i] * x[i];
      ss += __shfl_xor(ss, 1); ss += __shfl_xor(ss, 2); ss += __shfl_xor(ss, 4);
      const float r = rsqrtf(ss * (1.f / 128.f) + EPS) * 0.08838834764831845f; const int d0 = (16 * lane) & 127;
#pragma unroll
      for (int i = 0; i < 16; ++i) x[i] *= r * p.att_q_g[d0 + i];
      pack16(WSP(bf16, WS_AQN) + (size_t)bt * 1024 + 16 * lane, x); }
    { const unsigned w = *(const unsigned*)(pr + C_AK + 2 * lane); const float x0 = bflo(w), x1 = bfhi(w);
      const float r = rsqrtf(wave_sum(x0 * x0 + x1 * x1) * (1.f / 128.f) + EPS);
      *(unsigned*)(WSP(bf16, WS_AKN) + (size_t)bt * 128 + 2 * lane) = pk2(x0 * r * p.att_k_g[2 * lane], x1 * r * p.att_k_g[2 * lane + 1]);
      *(unsigned*)(WSP(bf16, WS_AVC) + (size_t)bt * 128 + 2 * lane) = *(const unsigned*)(pr + C_AV + 2 * lane); }
    { float x[16]; unpack16(pr + C_MQ + 16 * lane, x); float ss = 0.f;
#pragma unroll
      for (int i = 0; i < 16; ++i) ss += x[i] * x[i];
      ss += __shfl_xor(ss, 1); ss += __shfl_xor(ss, 2); ss += __shfl_xor(ss, 4); ss += __shfl_xor(ss, 8);
      const float r = rsqrtf(ss * (1.f / 256.f) + EPS) * 0.0625f; const int d0 = (16 * lane) & 255;
#pragma unroll
      for (int i = 0; i < 16; ++i) x[i] *= r * p.mem_q_g[d0 + i];
      pack16(WSP(bf16, WS_MQN) + (size_t)bt * 1024 + 16 * lane, x); }
}
__device__ __forceinline__ void unpack16v(const v4u a, const v4u b, float (&x)[16]) {
#pragma unroll
    for (int e = 0; e < 4; ++e) { x[2 * e] = bflo(a[e]); x[2 * e + 1] = bfhi(a[e]); x[8 + 2 * e] = bflo(b[e]); x[8 + 2 * e + 1] = bfhi(b[e]); }
}
__device__ __forceinline__ void norm_tokens4(const Params& p, int bt0, int stride, int lane) {
    const bf16* __restrict__ proj = WSP(const bf16, WS_PROJ);
    v4u aq[4][2], mq[4][2]; unsigned ak[4], av[4];
#pragma unroll
    for (int u = 0; u < 4; ++u) { const int bt = (bt0 + u * stride) < NT ? (bt0 + u * stride) : bt0; const bf16* pr = proj + (size_t)bt * LDP;
        aq[u][0] = *(const v4u*)(pr + C_AQ + 16 * lane); aq[u][1] = *(const v4u*)(pr + C_AQ + 16 * lane + 8);
        ak[u] = *(const unsigned*)(pr + C_AK + 2 * lane); av[u] = *(const unsigned*)(pr + C_AV + 2 * lane);
        mq[u][0] = *(const v4u*)(pr + C_MQ + 16 * lane); mq[u][1] = *(const v4u*)(pr + C_MQ + 16 * lane + 8); }
    float gq[16], gm[16];
    { const int dq = (16 * lane) & 127, dm = (16 * lane) & 255;
#pragma unroll
      for (int i = 0; i < 4; ++i) { const f32x4 a = *(const f32x4*)(p.att_q_g + dq + 4 * i), b = *(const f32x4*)(p.mem_q_g + dm + 4 * i);
          gq[4 * i] = a.x; gq[4 * i + 1] = a.y; gq[4 * i + 2] = a.z; gq[4 * i + 3] = a.w; gm[4 * i] = b.x; gm[4 * i + 1] = b.y; gm[4 * i + 2] = b.z; gm[4 * i + 3] = b.w; } }
    const float gk0 = p.att_k_g[2 * lane], gk1 = p.att_k_g[2 * lane + 1];
#pragma unroll
    for (int u = 0; u < 4; ++u) { const int bt = bt0 + u * stride; if (bt >= NT) break;
        { float x[16]; unpack16v(aq[u][0], aq[u][1], x); float ss = 0.f;
#pragma unroll
          for (int i = 0; i < 16; ++i) ss += x[i] * x[i];
          ss += __shfl_xor(ss, 1); ss += __shfl_xor(ss, 2); ss += __shfl_xor(ss, 4);
          const float r = rsqrtf(ss * (1.f / 128.f) + EPS) * 0.08838834764831845f;
#pragma unroll
          for (int i = 0; i < 16; ++i) x[i] *= r * gq[i];
          pack16(WSP(bf16, WS_AQN) + (size_t)bt * 1024 + 16 * lane, x); }
        { const float x0 = bflo(ak[u]), x1 = bfhi(ak[u]);
          const float r = rsqrtf(wave_sum(x0 * x0 + x1 * x1) * (1.f / 128.f) + EPS);
          *(unsigned*)(WSP(bf16, WS_AKN) + (size_t)bt * 128 + 2 * lane) = pk2(x0 * r * gk0, x1 * r * gk1);
          *(unsigned*)(WSP(bf16, WS_AVC) + (size_t)bt * 128 + 2 * lane) = av[u]; }
        { float x[16]; unpack16v(mq[u][0], mq[u][1], x); float ss = 0.f;
#pragma unroll
          for (int i = 0; i < 16; ++i) ss += x[i] * x[i];
          ss += __shfl_xor(ss, 1); ss += __shfl_xor(ss, 2); ss += __shfl_xor(ss, 4); ss += __shfl_xor(ss, 8);
          const float r = rsqrtf(ss * (1.f / 256.f) + EPS) * 0.0625f;
#pragma unroll
          for (int i = 0; i < 16; ++i) x[i] *= r * gm[i];
          pack16(WSP(bf16, WS_MQN) + (size_t)bt * 1024 + 16 * lane, x); }
    }
}
__device__ __forceinline__ void norm_memtoken(const Params& p, int m, int lane) {
    float x[16]; unpack16(WSP(const bf16, WS_MK) + (size_t)m * 1024 + 16 * lane, x); float ss = 0.f;
#pragma unroll
    for (int i = 0; i < 16; ++i) ss += x[i] * x[i];
    ss += __shfl_xor(ss, 1); ss += __shfl_xor(ss, 2); ss += __shfl_xor(ss, 4); ss += __shfl_xor(ss, 8);
    const float r = rsqrtf(ss * (1.f / 256.f) + EPS); const int d0 = (16 * lane) & 255;
#pragma unroll
    for (int i = 0; i < 16; ++i) x[i] *= r * p.mem_k_g[d0 + i];
    pack16(WSP(bf16, WS_MKN) + (size_t)m * 1024 + 16 * lane, x);
}
__device__ __forceinline__ void stage_rot(const bf16* __restrict__ src, int bt0, const int* __restrict__ pos, LAS unsigned char* dst, float lg, int mode, int tid) {
    v4u av[2], bv[2]; int pi[2];
#pragma unroll
    for (int it = 0; it < 2; ++it) { const int task = tid + it * NTHR, j = task >> 3, pc = task & 7; const bf16* rp = src + (size_t)(bt0 + j) * LDP + 8 * pc;
        av[it] = *(const v4u*)rp; bv[it] = *(const v4u*)(rp + 64); pi[it] = pos[bt0 + j]; }
#pragma unroll
    for (int it = 0; it < 2; ++it) {
        const int task = tid + it * NTHR, j = task >> 3, pc = task & 7;
        const v4u a = av[it], b = bv[it];
        const float ps = (float)pi[it];
        float sc = 1.f; if (mode >= 1) sc = 0.08838834764831845f; if (mode == 2) sc *= exp2f((float)(127 - j) * lg);
        float o1[8], o2[8];
#pragma unroll
        for (int e = 0; e < 8; ++e) {
            const float x1 = (e & 1) ? bfhi(a[e >> 1]) : bflo(a[e >> 1]), x2 = (e & 1) ? bfhi(b[e >> 1]) : bflo(b[e >> 1]);
            const float invf = exp2f(-(float)(8 * pc + e) * (13.287712379549449f / 64.f));
            float rev = ps * invf * 0.15915494309189535f; rev -= floorf(rev);
            const float sn = __builtin_amdgcn_sinf(rev), cs = __builtin_amdgcn_cosf(rev);
            o1[e] = (x1 * cs - x2 * sn) * sc; o2[e] = (x1 * sn + x2 * cs) * sc; }
        v4u w1, w2;
#pragma unroll
        for (int e = 0; e < 4; ++e) { w1[e] = pk2(o1[2 * e], o1[2 * e + 1]); w2[e] = pk2(o2[2 * e], o2[2 * e + 1]); }
        *(LAS v4u*)(dst + j * 288 + 16 * pc) = w1; *(LAS v4u*)(dst + j * 288 + 128 + 16 * pc) = w2;
    }
}
struct Tile256 { v4u t[8]; };
__device__ __forceinline__ void stage_256_load(const bf16* __restrict__ src, size_t ld, int tid, Tile256& r) {
#pragma unroll
    for (int i = 0; i < 8; ++i) { const int task = tid + i * NTHR, j = task >> 5, ch = task & 31; r.t[i] = *(const v4u*)(src + (size_t)j * ld + 8 * ch); }
}
__device__ __forceinline__ void stage_256_store(LAS unsigned char* dst, int tid, const Tile256& r) {
#pragma unroll
    for (int i = 0; i < 8; ++i) { const int task = tid + i * NTHR, j = task >> 5, ch = task & 31; *(LAS v4u*)(dst + j * 544 + 16 * ch) = r.t[i]; }
}
__device__ __forceinline__ float log2_gamma(int h) { return log2f(1.f - exp2f(-5.f - (float)h)); }
__device__ __forceinline__ void r1_item(const Params& p, LAS unsigned char* lds, int item, int tid, int wave, int lane) {
    const int bh = item >> 5, c = item & 31, b = bh >> 3, h = bh & 7, bt0 = b * SEQ + c * 128;
    const float lg = log2_gamma(h);
    const bf16* proj = WSP(const bf16, WS_PROJ);
    LAS unsigned char* Kl = lds; LAS unsigned char* Vl = lds + 36864;
    { Tile256 vt; stage_256_load(proj + (size_t)bt0 * LDP + C_RV + h * 256, LDP, tid, vt); stage_256_store(Vl, tid, vt); }
    stage_rot(proj + C_RK + h * 128, bt0, p.pos, Kl, lg, 2, tid);
    __syncthreads();
    const int g = lane >> 4, n = lane & 15, q4 = n >> 2, pp = lane & 3;
    f32x4 acc[16];
#pragma unroll
    for (int nt = 0; nt < 16; ++nt) acc[nt] = (f32x4){0.f, 0.f, 0.f, 0.f};
#pragma unroll
    for (int ks = 0; ks < 4; ++ks) {
        const int row0 = 32 * ks + 8 * g + q4;
        const unsigned ka = lds_addr(Kl) + row0 * 288 + (16 * wave + 4 * pp) * 2;
        const bf16x8 kf = tr_read8(ka, ka + 4 * 288);
        const unsigned va = lds_addr(Vl) + row0 * 544 + (4 * pp) * 2;
#pragma unroll
        for (int nb = 0; nb < 4; ++nb) { bf16x8 vf[4]; tr_read8x4(va + 128 * nb, va + 128 * nb + 4 * 544, vf);
#pragma unroll
            for (int q = 0; q < 4; ++q) acc[4 * nb + q] = mfma16(vf[q], kf, acc[4 * nb + q]); }
    }
    float* o = WSP(float, WS_SC) + (size_t)item * 32768 + (16 * wave + n) * 256 + 4 * g;
#pragma unroll
    for (int nt = 0; nt < 16; ++nt) *(f32x4*)(o + 16 * nt) = acc[nt];
    __syncthreads();
}
__device__ __forceinline__ void a1_item(const Params& p, LAS unsigned char* lds, int item, int tid, int wave, int lane) {
    const int b = item >> 8, qt = item & 255, bt0 = b * SEQ + 16 * qt;
    const bf16* proj = WSP(const bf16, WS_PROJ);
    {   v4u qv[4];
#pragma unroll
        for (int it = 0; it < 4; ++it) { const int task = tid + it * NTHR, q = task >> 7, ch = task & 127; qv[it] = *(const v4u*)(proj + (size_t)(bt0 + q) * LDP + C_IQ + 8 * ch); }
#pragma unroll
        for (int it = 0; it < 4; ++it) { const int task = tid + it * NTHR, q = task >> 7, ch = task & 127, h = ch >> 3, c8 = ch & 7; *(LAS v4u*)(lds + (h * 16 + q) * 144 + 16 * c8) = qv[it]; } }
    const int g = lane >> 4, n = lane & 15;
    LAS float* wl = (LAS float*)(lds + 36864);
    if (tid < 256) { const unsigned short wv = *(proj + (size_t)(bt0 + (tid >> 4)) * LDP + C_IW + (tid & 15)); wl[tid] = __uint_as_float(((unsigned)wv) << 16) * 0.03125f; }
    __syncthreads();
    float* scores = WSP(float, WS_SCORES);
    bf16x8 na0, na1;
    { const int kt0 = wave <= qt ? wave : 0; const bf16* kp = proj + (size_t)(b * SEQ + 16 * kt0 + n) * LDP + C_IK + 8 * g; na0 = *(const bf16x8*)kp; na1 = *(const bf16x8*)(kp + 32); }
    for (int kt = wave; kt <= qt; kt += NWAVES) {
        const bf16x8 a0 = na0, a1 = na1;
        { const int ktn = kt + NWAVES <= qt ? kt + NWAVES : kt; const bf16* kp = proj + (size_t)(b * SEQ + 16 * ktn + n) * LDP + C_IK + 8 * g; na0 = *(const bf16x8*)kp; na1 = *(const bf16x8*)(kp + 32); }
        f32x4 sc = (f32x4){0.f, 0.f, 0.f, 0.f};
#pragma unroll 4
        for (int h = 0; h < 16; ++h) {
            const bf16x8 b0 = *(const LAS bf16x8*)(lds + (h * 16 + n) * 144 + 16 * g), b1 = *(const LAS bf16x8*)(lds + (h * 16 + n) * 144 + 64 + 16 * g);
            const float wh = wl[n * 16 + h];
            f32x4 cc = mfma16(a0, b0, (f32x4){0.f, 0.f, 0.f, 0.f}); cc = mfma16(a1, b1, cc);
#pragma unroll
            for (int r = 0; r < 4; ++r) sc[r] += wh * fmaxf(cc[r], 0.f);
        }
        *(f32x4*)(scores + (size_t)(bt0 + n) * SEQ + 16 * kt + 4 * g) = sc;
    }
    __syncthreads();
}
__device__ __forceinline__ void phase2a(const Params& p, LAS unsigned char* lds, int tid, int wave, int lane) {
    const int gw = blockIdx.x * NWAVES + wave, NGW = gridDim.x * NWAVES;
    for (int bt = gw; bt < NT; bt += 4 * NGW) norm_tokens4(p, bt, NGW, lane);
    for (int m = gw; m < NMEM; m += NGW) norm_memtoken(p, m, lane);
#ifndef SUBREP
#define SUBREP 0
#endif
    for (int rep = 0; rep < ((SUBREP & 8) ? 2 : 1); ++rep)
    for (int it = blockIdx.x; it < 512; it += gridDim.x) r1_item(p, lds, it, tid, wave, lane);
    for (int rep = 0; rep < ((SUBREP & 16) ? 2 : 1); ++rep)
    for (int it = blockIdx.x; it < 256; it += gridDim.x) { a1_item(p, lds, it, tid, wave, lane); a1_item(p, lds, 511 - it, tid, wave, lane); }
}

__device__ __forceinline__ unsigned okey(float v) { const unsigned u = __float_as_uint(v); return (u & 0x80000000u) ? ~u : (u | 0x80000000u); }
template <int NJ>
__device__ __forceinline__ void a2_row(const Params& p, LAS unsigned* hist, int bt, int lane) {
    const int t = bt & (SEQ - 1), n = t + 1;
    unsigned short* out = WSP(unsigned short, WS_IDX) + (size_t)bt * 256;
    if (n <= 256) { for (int s = lane; s < n; s += 64) out[s] = (unsigned short)s; return; }
    const float* row = WSP(const float, WS_SCORES) + (size_t)bt * SEQ;
    unsigned key[NJ];
#pragma unroll
    for (int j = 0; j < NJ; ++j) { const int s = 64 * j + lane; key[j] = __float_as_uint(row[s < n ? s : n - 1]); }
#pragma unroll
    for (int j = 0; j < NJ; ++j) { const int s = 64 * j + lane; key[j] = s < n ? okey(__uint_as_float(key[j])) : 0u; }
    unsigned kmax = 0u, kmin = 0xffffffffu;
#pragma unroll
    for (int j = 0; j < NJ; ++j) { kmax = max(kmax, key[j]); kmin = min(kmin, key[j] ? key[j] : 0xffffffffu); }
#pragma unroll
    for (int o = 1; o < 64; o <<= 1) { kmax = max(kmax, (unsigned)__shfl_xor((int)kmax, o)); kmin = min(kmin, (unsigned)__shfl_xor((int)kmin, o)); }
    kmax = (unsigned)__builtin_amdgcn_readfirstlane((int)kmax); kmin = (unsigned)__builtin_amdgcn_readfirstlane((int)kmin);
    unsigned T = kmax; int need = 256;
    const unsigned diff = kmax ^ kmin;
    if (diff != 0u) {
        int hi = 31 - __builtin_clz(diff);
        T = (hi == 31) ? 0u : (kmax >> (hi + 1)) << (hi + 1);
        while (hi >= 0) {
            const int lo = hi >= 7 ? hi - 7 : 0; const unsigned dmask = (1u << (hi - lo + 1)) - 1u;
            *(LAS v4u*)(hist + 4 * lane) = (v4u){0u, 0u, 0u, 0u};
            LDS_WAIT(); asm volatile("" ::: "memory");
#pragma unroll
            for (int j = 0; j < NJ; ++j) { const bool m = (hi == 31) ? (key[j] != 0u) : ((((key[j] ^ T) >> (hi + 1)) == 0u) && key[j] != 0u);
                if (m) __hip_atomic_fetch_add(hist + ((key[j] >> lo) & dmask), 1u, __ATOMIC_RELAXED, __HIP_MEMORY_SCOPE_WORKGROUP); }
            LDS_WAIT(); asm volatile("" ::: "memory");
            const v4u h4 = *(const LAS v4u*)(hist + 4 * lane);
            const int tot = (int)(h4.x + h4.y + h4.z + h4.w);
            int incl = tot;
#pragma unroll
            for (int o = 1; o < 64; o <<= 1) { const int v = __shfl_up(incl, o); if (lane >= o) incl += v; }
            const int total = __builtin_amdgcn_readlane(incl, 63);
            const int above_l = total - incl;
            const bool here = (above_l < need) && (need <= above_l + tot);
            const int c3 = above_l + (int)h4.w, c2 = c3 + (int)h4.z, c1 = c2 + (int)h4.y;
            int d_l, ab_l, cn_l;
            if (c3 >= need) { d_l = 4 * lane + 3; ab_l = above_l; cn_l = (int)h4.w; } else if (c2 >= need) { d_l = 4 * lane + 2; ab_l = c3; cn_l = (int)h4.z; }
            else if (c1 >= need) { d_l = 4 * lane + 1; ab_l = c2; cn_l = (int)h4.y; } else { d_l = 4 * lane; ab_l = c1; cn_l = (int)h4.x; }
            const unsigned long long hm = __ballot(here);
            const int src = hm ? (int)__builtin_ctzll(hm) : 0;
            const int d = __builtin_amdgcn_readlane(d_l, src), ab = __builtin_amdgcn_readlane(ab_l, src), cn = __builtin_amdgcn_readlane(cn_l, src);
            T |= (unsigned)d << lo; need -= ab;
            if (cn == need) break;
            hi = lo - 1;
        }
    }
    const unsigned long long lt = (1ull << lane) - 1ull;
    LAS unsigned short* lst = (LAS unsigned short*)hist;
    int posn = 0;
#pragma unroll
    for (int j = 0; j < NJ; ++j) { const bool pred = key[j] > T; const unsigned long long mask = __ballot(pred); const int off = posn + __popcll(mask & lt);
        if (pred) lst[off] = (unsigned short)(64 * j + lane); posn += __popcll(mask); }
#pragma unroll
    for (int j = 0; j < NJ; ++j) { const bool pred = key[j] == T; const unsigned long long mask = __ballot(pred); const int off = posn + __popcll(mask & lt);
        if (pred && off < 256) lst[off] = (unsigned short)(64 * j + lane); posn += __popcll(mask); }
    LDS_WAIT(); asm volatile("" ::: "memory");
    *(v2u*)(out + 4 * lane) = *(const LAS v2u*)(lst + 4 * lane);
    LDS_WAIT(); asm volatile("" ::: "memory");
}
__device__ __forceinline__ void phase2b(const Params& p, LAS unsigned char* lds, int tid, int wave, int lane) {
    const float* Sc = WSP(const float, WS_SC); bf16* ST = WSP(bf16, WS_ST);
    for (int id0 = blockIdx.x * NTHR + tid; id0 < ((SUBREP & 1024) ? 2 : 1) * 16 * 8192; id0 += gridDim.x * NTHR) {
        const int id = id0 & (16 * 8192 - 1); const int bh = id >> 13, e4 = id & 8191; const float cd = exp2f(128.f * log2_gamma(bh & 7));
        f32x4 st = (f32x4){0.f, 0.f, 0.f, 0.f};
        const float* __restrict__ sp = Sc + (size_t)(bh * 32) * 32768 + 4 * e4; bf16* __restrict__ op = ST + (size_t)(bh * 32) * 32768 + 4 * e4;
#pragma unroll 1
        for (int c0 = 0; c0 < 32; c0 += 8) {
            f32x4 s[8];
#pragma unroll
            for (int j = 0; j < 8; ++j) s[j] = *(const f32x4*)(sp + (size_t)(c0 + j) * 32768);
#pragma unroll
            for (int j = 0; j < 8; ++j) { v2u o; o.x = pk2(st.x, st.y); o.y = pk2(st.z, st.w); *(v2u*)(op + (size_t)(c0 + j) * 32768) = o; st = st * cd + s[j]; }
        }
    }
    const int gw = blockIdx.x * NWAVES + wave, NGW = gridDim.x * NWAVES;
#pragma unroll 1
    for (int i = gw; i < NT; i += NGW) {
        const int u = i & (SEQ - 1), t = u < SEQ / 2 ? u : (SEQ + SEQ / 2 - 1) - u, bt = (i & ~(SEQ - 1)) | t;
        LAS unsigned* hist = (LAS unsigned*)(lds + wave * 1024);
        if (t < 1024) a2_row<16>(p, hist, bt, lane); else if (t < 2048) a2_row<32>(p, hist, bt, lane);
        else if (t < 3072) a2_row<48>(p, hist, bt, lane); else a2_row<64>(p, hist, bt, lane);
    }
}

__device__ __forceinline__ v2u pack4(float a, float b, float c, float d) { v2u o; o.x = pk2(a, b); o.y = pk2(c, d); return o; }
__device__ __forceinline__ void r3_item(const Params& p, LAS unsigned char* lds, int item, int tid, int wave, int lane) {
    const int bh = item >> 5, c = item & 31, b = bh >> 3, h = bh & 7, bt0 = b * SEQ + c * 128;
    const float lg = log2_gamma(h);
    const bf16* proj = WSP(const bf16, WS_PROJ);
    LAS unsigned char* Ql = lds; LAS unsigned char* Kl = lds + 36864; LAS unsigned char* Vl = lds + 73728;
    {   Tile256 st; stage_256_load(WSP(const bf16, WS_ST) + (size_t)item * 32768, 256, tid, st);
        stage_rot(proj + C_RQ + h * 128, bt0, p.pos, Ql, lg, 0, tid);
        stage_rot(proj + C_RK + h * 128, bt0, p.pos, Kl, lg, 1, tid);
        stage_256_store(Vl, tid, st); }
    __syncthreads();
    const int g = lane >> 4, n = lane & 15, q4 = n >> 2, pp = lane & 3;
    const int i = 16 * wave + n;
    f32x4 sacc[8];
#pragma unroll
    for (int jt = 0; jt < 8; ++jt) sacc[jt] = (f32x4){0.f, 0.f, 0.f, 0.f};
    f32x4 oacc[16];
#pragma unroll
    for (int nt = 0; nt < 16; ++nt) oacc[nt] = (f32x4){0.f, 0.f, 0.f, 0.f};
#pragma unroll 1
    for (int ks = 0; ks < 4; ++ks) {
        const bf16x8 qf = *(const LAS bf16x8*)(Ql + i * 288 + 64 * ks + 16 * g);
#pragma unroll
        for (int jt = 0; jt < 8; ++jt) { const bf16x8 kf = *(const LAS bf16x8*)(Kl + (16 * jt + n) * 288 + 64 * ks + 16 * g); sacc[jt] = mfma16(kf, qf, sacc[jt]); }
        const unsigned sa = lds_addr(Vl) + (32 * ks + 8 * g + q4) * 544 + (4 * pp) * 2;
#pragma unroll
        for (int nb = 0; nb < 4; ++nb) { bf16x8 sf[4]; tr_read8x4(sa + 128 * nb, sa + 128 * nb + 4 * 544, sf);
#pragma unroll
            for (int q = 0; q < 4; ++q) oacc[4 * nb + q] = mfma16(sf[q], qf, oacc[4 * nb + q]); }
    }
    const float qd = exp2f((float)(i + 1) * lg);
#pragma unroll
    for (int nt = 0; nt < 16; ++nt) oacc[nt] = oacc[nt] * qd;
    __syncthreads();
#pragma unroll
    for (int jt = 0; jt < 8; ++jt) { float pv[4];
#pragma unroll
        for (int r = 0; r < 4; ++r) { const int j = 16 * jt + 4 * g + r; pv[r] = (i >= j) ? sacc[jt][r] * exp2f((float)(i - j) * lg) : 0.f; }
        *(LAS v2u*)(Kl + i * 288 + (16 * jt + 4 * g) * 2) = pack4(pv[0], pv[1], pv[2], pv[3]); }
    { Tile256 vt; stage_256_load(proj + (size_t)bt0 * LDP + C_RV + h * 256, LDP, tid, vt); stage_256_store(Vl, tid, vt); }
    __syncthreads();
#pragma unroll 1
    for (int ks = 0; ks < 4; ++ks) {
        const bf16x8 pf = *(const LAS bf16x8*)(Kl + i * 288 + 64 * ks + 16 * g);
        const unsigned va = lds_addr(Vl) + (32 * ks + 8 * g + q4) * 544 + (4 * pp) * 2;
#pragma unroll
        for (int nb = 0; nb < 4; ++nb) { bf16x8 vf[4]; tr_read8x4(va + 128 * nb, va + 128 * nb + 4 * 544, vf);
#pragma unroll
            for (int q = 0; q < 4; ++q) oacc[4 * nb + q] = mfma16(vf[q], pf, oacc[4 * nb + q]); }
    }
    float ss = 0.f;
#pragma unroll
    for (int nt = 0; nt < 16; ++nt)
#pragma unroll
        for (int r = 0; r < 4; ++r) ss += oacc[nt][r] * oacc[nt][r];
    ss += __shfl_xor(ss, 16); ss += __shfl_xor(ss, 32);
    const float rn = rsqrtf(ss * (1.f / 256.f) + EPS);
    const bf16* __restrict__ gp = proj + (size_t)(bt0 + i) * LDP + C_RG + h * 256 + 4 * g; bf16* __restrict__ yp = WSP(bf16, WS_Y) + (size_t)(bt0 + i) * DM + h * 256 + 4 * g;
#pragma unroll
    for (int nt = 0; nt < 16; ++nt) { const v2u gw = *(const v2u*)(gp + 16 * nt); float gt[4] = {bflo(gw.x), bfhi(gw.x), bflo(gw.y), bfhi(gw.y)}; float y[4];
#pragma unroll
        for (int r = 0; r < 4; ++r) y[r] = gt[r] / (1.f + __expf(-gt[r])) * oacc[nt][r] * rn;
        *(v2u*)(yp + 16 * nt) = pack4(y[0], y[1], y[2], y[3]); }
    __syncthreads();
}
__device__ __forceinline__ int t5_bucket(int n) {
    if (n < 16) return n;
    const int l = 16 + (int)(logf((float)n * 0.0625f) / 2.0794415416798357f * 16.f);
    return l < 31 ? l : 31;
}
constexpr int A3_VROW = 272, A3_VBYTES = 64 * A3_VROW, A3_TAB = 8 * A3_VBYTES, A3_IDX = A3_TAB + 4096 + 1024;
static_assert(A3_IDX + 8 * 512 <= LDS_SCR, "A3 LDS map");
__device__ __forceinline__ void a3_tables(const Params& p, LAS unsigned char* lds, int tid) {
    for (int d = tid; d < 4096; d += NTHR) lds[A3_TAB + d] = (unsigned char)t5_bucket(d);
    if (tid < 256) ((LAS float*)(lds + A3_TAB + 4096))[tid] = p.rel_bias[tid];
    __syncthreads();
}
struct A3In { v2u iv; bf16x8 qf[4]; };
__device__ __forceinline__ void a3_fetch(const Params& p, int bt, int lane, A3In& in) {
    const int g = lane >> 4, n = lane & 15;
    in.iv = *(const v2u*)(WSP(const unsigned short, WS_IDX) + (size_t)bt * 256 + 4 * lane);
#pragma unroll
    for (int ks = 0; ks < 4; ++ks) { in.qf[ks] = (bf16x8){0, 0, 0, 0, 0, 0, 0, 0}; if (n < 8) in.qf[ks] = *(const bf16x8*)(WSP(const bf16, WS_AQN) + (size_t)bt * 1024 + n * 128 + 32 * ks + 8 * g); }
}
__device__ __forceinline__ void a3_query(const Params& p, LAS unsigned char* lds, int bt, int wave, int lane, const A3In& in) {
    const int b = bt >> 12, t = bt & (SEQ - 1), cnt = (t + 1 < 256) ? (t + 1) : 256;
    const int g = lane >> 4, n = lane & 15, q4 = n >> 2, pp = lane & 3;
    const bf16* akn = WSP(const bf16, WS_AKN) + (size_t)b * SEQ * 128; const bf16* avc = WSP(const bf16, WS_AVC) + (size_t)b * SEQ * 128;
    LAS unsigned char* Vl = lds + wave * A3_VBYTES;
    const LAS unsigned char* bkt = lds + A3_TAB; const LAS float* rbl = (const LAS float*)(lds + A3_TAB + 4096);
    LAS unsigned short* il = (LAS unsigned short*)(lds + A3_IDX + wave * 512);
    {
        v2u iv = in.iv;
        if (4 * lane + 0 >= cnt) iv.x &= 0xffff0000u; if (4 * lane + 1 >= cnt) iv.x &= 0x0000ffffu; if (4 * lane + 2 >= cnt) iv.y &= 0xffff0000u; if (4 * lane + 3 >= cnt) iv.y &= 0x0000ffffu;
        *(LAS v2u*)(il + 4 * lane) = iv;
    }
    bf16x8 qf[4];
#pragma unroll
    for (int ks = 0; ks < 4; ++ks) qf[ks] = in.qf[ks];
    LDS_WAIT(); asm volatile("" ::: "memory");
    float pr[16][4];
#pragma unroll
    for (int kb = 0; kb < 4; ++kb) {
        bf16x8 kf[4][4];
#pragma unroll
        for (int j = 0; j < 4; ++j) { const bf16* kp = akn + (size_t)il[16 * (4 * kb + j) + n] * 128 + 8 * g;
#pragma unroll
            for (int ks = 0; ks < 4; ++ks) kf[j][ks] = *(const bf16x8*)(kp + 32 * ks); }
#pragma unroll
        for (int j = 0; j < 4; ++j) { const int kt = 4 * kb + j;
            f32x4 cc = (f32x4){0.f, 0.f, 0.f, 0.f};
#pragma unroll
            for (int ks = 0; ks < 4; ++ks) cc = mfma16(kf[j][ks], qf[ks], cc);
            const v2u i4 = *(const LAS v2u*)(il + 16 * kt + 4 * g);
            const int k4[4] = {(int)(i4.x & 0xffffu), (int)(i4.x >> 16), (int)(i4.y & 0xffffu), (int)(i4.y >> 16)};
#pragma unroll
            for (int r = 0; r < 4; ++r) { const bool valid = (16 * kt + 4 * g + r) < cnt; const int dist = valid ? t - k4[r] : 0;
                pr[kt][r] = valid ? cc[r] + rbl[(int)bkt[dist & 4095] * 8 + (n & 7)] : -INFINITY; } }
    }
    float m = pr[0][0];
#pragma unroll
    for (int kt = 0; kt < 16; ++kt)
#pragma unroll
        for (int r = 0; r < 4; ++r) m = fmaxf(m, pr[kt][r]);
    m = fmaxf(m, __shfl_xor(m, 16)); m = fmaxf(m, __shfl_xor(m, 32));
    float s = 0.f;
#pragma unroll
    for (int kt = 0; kt < 16; ++kt)
#pragma unroll
        for (int r = 0; r < 4; ++r) { const float e = exp2f((pr[kt][r] - m) * 1.4426950408889634f); pr[kt][r] = e; s += e; }
    s += __shfl_xor(s, 16); s += __shfl_xor(s, 32);
    const float inv = 1.f / s;
    f32x4 acc[8];
#pragma unroll
    for (int dt = 0; dt < 8; ++dt) acc[dt] = (f32x4){0.f, 0.f, 0.f, 0.f};
    v4u vv[16];
#pragma unroll
    for (int i = 0; i < 16; ++i) vv[i] = *(const v4u*)(avc + (size_t)il[g + 4 * i] * 128 + 8 * n);
#pragma unroll
    for (int ch = 0; ch < 4; ++ch) {
        if (64 * ch < cnt) {
#pragma unroll
            for (int i = 0; i < 16; ++i) *(LAS v4u*)(Vl + (g + 4 * i) * A3_VROW + 16 * n) = vv[i];
            if (ch < 3 && 64 * (ch + 1) < cnt) {
#pragma unroll
                for (int i = 0; i < 16; ++i) vv[i] = *(const v4u*)(avc + (size_t)il[64 * (ch + 1) + g + 4 * i] * 128 + 8 * n);
            }
            LDS_WAIT(); asm volatile("" ::: "memory");
#pragma unroll
            for (int s2 = 0; s2 < 2; ++s2) {
                const int jt0 = 4 * ch + 2 * s2;
                bf16x8 pb; { const v2u lo = pack4(pr[jt0][0] * inv, pr[jt0][1] * inv, pr[jt0][2] * inv, pr[jt0][3] * inv), hi = pack4(pr[jt0 + 1][0] * inv, pr[jt0 + 1][1] * inv, pr[jt0 + 1][2] * inv, pr[jt0 + 1][3] * inv);
                    union { v4u u; bf16x8 h; } cv; cv.u = (v4u){lo.x, lo.y, hi.x, hi.y}; pb = cv.h; }
                const unsigned a0 = lds_addr(Vl) + (32 * s2 + 4 * g + q4) * A3_VROW + 8 * pp, a1 = a0 + 16 * A3_VROW;
                bf16x8 vf[4];
                tr_read8x4(a0, a1, vf);
#pragma unroll
                for (int j = 0; j < 4; ++j) acc[j] = mfma16(vf[j], pb, acc[j]);
                tr_read8x4(a0 + 128, a1 + 128, vf);
#pragma unroll
                for (int j = 0; j < 4; ++j) acc[4 + j] = mfma16(vf[j], pb, acc[4 + j]);
            }
        }
    }
    if (n < 8) { bf16* yp = WSP(bf16, WS_Y) + (size_t)bt * DM + 2048 + n * 128 + 4 * g;
#pragma unroll
        for (int dt = 0; dt < 8; ++dt) *(v2u*)(yp + 16 * dt) = pack4(acc[dt][0], acc[dt][1], acc[dt][2], acc[dt][3]); }
}
__device__ __forceinline__ void m_item(const Params& p, LAS unsigned char* lds, int item, int tid, int wave, int lane) {
    const int b = item >> 7, head = (item >> 5) & 3, qb = item & 31, bt0 = b * SEQ + 128 * qb;
    LAS unsigned char* R1 = lds; LAS unsigned char* R2 = lds + 73728;
    const bf16* mkn = WSP(const bf16, WS_MKN); const bf16* mqn = WSP(const bf16, WS_MQN); const bf16* mvT = WSP(const bf16, WS_MVT);
    const int g = lane >> 4, n = lane & 15, i = 16 * wave + n;
    f32x4 sacc[16];
#pragma unroll
    for (int mt = 0; mt < 16; ++mt) sacc[mt] = (f32x4){0.f, 0.f, 0.f, 0.f};
    for (int hh = 0; hh < 2; ++hh) {
        if (hh) __syncthreads();
        {   v4u kv[8], qv[4];
#pragma unroll
            for (int it = 0; it < 8; ++it) { const int task = tid + it * NTHR, m = task >> 4, ch = task & 15; kv[it] = *(const v4u*)(mkn + (size_t)(b * MEML + m) * 1024 + head * 256 + 128 * hh + 8 * ch); }
#pragma unroll
            for (int it = 0; it < 4; ++it) { const int task = tid + it * NTHR, q = task >> 4, ch = task & 15; qv[it] = *(const v4u*)(mqn + (size_t)(bt0 + q) * 1024 + head * 256 + 128 * hh + 8 * ch); }
#pragma unroll
            for (int it = 0; it < 8; ++it) { const int task = tid + it * NTHR, m = task >> 4, ch = task & 15; *(LAS v4u*)(R1 + m * 288 + 16 * ch) = kv[it]; }
#pragma unroll
            for (int it = 0; it < 4; ++it) { const int task = tid + it * NTHR, q = task >> 4, ch = task & 15; *(LAS v4u*)(R2 + q * 288 + 16 * ch) = qv[it]; } }
        __syncthreads();
#pragma unroll 1
        for (int ks = 0; ks < 4; ++ks) { const bf16x8 qf = *(const LAS bf16x8*)(R2 + i * 288 + 64 * ks + 16 * g);
#pragma unroll
            for (int mt = 0; mt < 16; ++mt) { const bf16x8 kf = *(const LAS bf16x8*)(R1 + (16 * mt + n) * 288 + 64 * ks + 16 * g); sacc[mt] = mfma16(kf, qf, sacc[mt]); } }
    }
    float mx = -INFINITY;
#pragma unroll
    for (int mt = 0; mt < 16; ++mt)
#pragma unroll
        for (int r = 0; r < 4; ++r) mx = fmaxf(mx, sacc[mt][r]);
    mx = fmaxf(mx, __shfl_xor(mx, 16)); mx = fmaxf(mx, __shfl_xor(mx, 32));
    float sm = 0.f;
#pragma unroll
    for (int mt = 0; mt < 16; ++mt)
#pragma unroll
        for (int r = 0; r < 4; ++r) { const float e = exp2f((sacc[mt][r] - mx) * 1.4426950408889634f); sacc[mt][r] = e; sm += e; }
    sm += __shfl_xor(sm, 16); sm += __shfl_xor(sm, 32);
    const float inv = 1.f / sm;
    __syncthreads();
#pragma unroll
    for (int mt = 0; mt < 16; ++mt) *(LAS v2u*)(R2 + i * 544 + (16 * mt + 4 * g) * 2) = pack4(sacc[mt][0] * inv, sacc[mt][1] * inv, sacc[mt][2] * inv, sacc[mt][3] * inv);
    f32x4 oacc[16];
#pragma unroll
    for (int dt = 0; dt < 16; ++dt) oacc[dt] = (f32x4){0.f, 0.f, 0.f, 0.f};
    for (int hh = 0; hh < 2; ++hh) {
        if (hh) __syncthreads();
        {   v4u vv[8];
#pragma unroll
            for (int it = 0; it < 8; ++it) { const int task = tid + it * NTHR, d = task >> 4, ch = task & 15; vv[it] = *(const v4u*)(mvT + (size_t)(head * 256 + d) * 512 + b * MEML + 128 * hh + 8 * ch); }
#pragma unroll
            for (int it = 0; it < 8; ++it) { const int task = tid + it * NTHR, d = task >> 4, ch = task & 15; *(LAS v4u*)(R1 + d * 288 + 16 * ch) = vv[it]; } }
        __syncthreads();
#pragma unroll 1
        for (int ks = 0; ks < 4; ++ks) { const bf16x8 pf = *(const LAS bf16x8*)(R2 + i * 544 + (128 * hh + 32 * ks + 8 * g) * 2);
#pragma unroll
            for (int dt = 0; dt < 16; ++dt) { const bf16x8 vf = *(const LAS bf16x8*)(R1 + (16 * dt + n) * 288 + 64 * ks + 16 * g); oacc[dt] = mfma16(vf, pf, oacc[dt]); } }
    }
    bf16* yp = WSP(bf16, WS_Y) + (size_t)(bt0 + i) * DM + 3072 + head * 256 + 4 * g;
#pragma unroll
    for (int dt = 0; dt < 16; ++dt) *(v2u*)(yp + 16 * dt) = pack4(oacc[dt][0], oacc[dt][1], oacc[dt][2], oacc[dt][3]);
    __syncthreads();
}
__device__ __forceinline__ int a3_next(LAS unsigned* qhead, int lane) {
    int v = 0; if (lane == 0) v = (int)__hip_atomic_fetch_add(qhead, 1u, __ATOMIC_RELAXED, __HIP_MEMORY_SCOPE_WORKGROUP);
    return __builtin_amdgcn_readfirstlane(v);
}
__device__ __forceinline__ void phase2c(const Params& p, LAS unsigned char* lds, int tid, int wave, int lane) {
#ifndef SUBREP
#define SUBREP 0
#endif
    for (int rep = 0; rep < ((SUBREP & 1) ? 2 : 1); ++rep)
    for (int it = blockIdx.x; it < 512; it += gridDim.x) r3_item(p, lds, it, tid, wave, lane);
    for (int rep = 0; rep < ((SUBREP & 2) ? 2 : 1); ++rep)
    for (int it = blockIdx.x; it < 256; it += gridDim.x) m_item(p, lds, it, tid, wave, lane);
    const int NGW = gridDim.x * NWAVES;
    a3_tables(p, lds, tid);
    constexpr int NQW = 6;
    LAS unsigned* qhead = (LAS unsigned*)(lds + LDSCTL_OFF) + 8;
    if (wave >= NQW) convert_rows_wave(p, (int)blockIdx.x * (NWAVES - NQW) + (wave - NQW), (int)gridDim.x * (NWAVES - NQW), lane);
    {
        const int xb = blockIdx.x & 1, step = NGW >> 1, t00 = (blockIdx.x >> 1) * NWAVES, nj = NWAVES * (SEQ / step);
        A3In nx; int j = a3_next(qhead, lane);
        if (j < nj) a3_fetch(p, xb * SEQ + t00 + (j & 7) + (j >> 3) * step, lane, nx);
        while (j < nj) { const A3In cur = nx; const int jn = a3_next(qhead, lane);
            if (jn < nj) a3_fetch(p, xb * SEQ + t00 + (jn & 7) + (jn >> 3) * step, lane, nx);
            a3_query(p, lds, xb * SEQ + t00 + (j & 7) + (j >> 3) * step, wave, lane, cur); j = jn; }
    }
}

__device__ __forceinline__ int ord_key(float v) { const int b = __float_as_int(v); return b ^ ((b >> 31) & 0x7fffffff); }
__device__ __forceinline__ float ord_val(int k) { return __int_as_float(k ^ ((k >> 31) & 0x7fffffff)); }
__device__ __forceinline__ int med3i(int a, int b, int c) { int r; asm("v_med3_i32 %0, %1, %2, %3" : "=v"(r) : "v"(a), "v"(b), "v"(c)); return r; }
#define KINS16(tv, vin) do { const int v_ = (vin); _Pragma("unroll") for (int k_ = 15; k_ >= 1; --k_) tv[k_] = med3i(tv[k_ - 1], tv[k_], v_); tv[0] = max(tv[0], v_); } while (0)
#define KMERGE16(a, b) do { _Pragma("unroll") for (int i_ = 0; i_ < 16; ++i_) a[i_] = max(a[i_], b[15 - i_]); \
    _Pragma("unroll") for (int st_ = 8; st_ >= 1; st_ >>= 1) { _Pragma("unroll") for (int i_ = 0; i_ < 16; ++i_) if ((i_ & st_) == 0) { const int hi_ = max(a[i_], a[i_ + st_]), lo_ = min(a[i_], a[i_ + st_]); a[i_] = hi_; a[i_ + st_] = lo_; } } } while (0)
constexpr int P7_IL = 133120;
__device__ __forceinline__ void p7_item(const Params& p, LAS unsigned char* lds, int item, int tid, int wave, int lane) {
    const int tb = item >> 3, h = item & 7, t0 = tb * 128;
    LAS unsigned char* Al = lds; LAS unsigned char* Bl = lds + 69632;
    const bf16* qp = WSP(const bf16, WS_QP); const bf16* skb = WSP(const bf16, WS_SKB);
    {   v4u qa[8], kb[8];
#pragma unroll
        for (int it = 0; it < 8; ++it) { const int task = tid + it * NTHR, tt = task >> 5, ch = task & 31; qa[it] = *(const v4u*)(qp + (size_t)(t0 + tt) * 2048 + h * 256 + 8 * ch); }
#pragma unroll
        for (int it = 0; it < 8; ++it) { const int task = tid + it * NTHR, rr = task >> 4, ch = task & 15; kb[it] = *(const v4u*)(skb + (size_t)(h * 256 + rr) * 128 + 8 * ch); }
#pragma unroll
        for (int it = 0; it < 8; ++it) { const int task = tid + it * NTHR, tt = task >> 5, ch = task & 31; *(LAS v4u*)(Al + tt * 544 + 16 * ch) = qa[it]; }
#pragma unroll
        for (int it = 0; it < 8; ++it) { const int task = tid + it * NTHR, rr = task >> 4, ch = task & 15; *(LAS v4u*)(Bl + rr * 288 + 16 * ch) = kb[it]; } }
    __syncthreads();
    const int g = lane >> 4, n = lane & 15;
    f32x4 acc[2][8];
#pragma unroll
    for (int c = 0; c < 2; ++c)
#pragma unroll
        for (int nt = 0; nt < 8; ++nt) { acc[c][nt] = (f32x4){0.f, 0.f, 0.f, 0.f};
#pragma unroll
            for (int ks = 0; ks < 4; ++ks) { const bf16x8 af = *(const LAS bf16x8*)(Al + (16 * wave + n) * 544 + (c * 128 + 32 * ks + 8 * g) * 2);
                const bf16x8 bf = *(const LAS bf16x8*)(Bl + (c * 128 + 16 * nt + n) * 288 + 64 * ks + 16 * g); acc[c][nt] = mfma16(af, bf, acc[c][nt]); } }
    __syncthreads();
    LAS float* sl = (LAS float*)lds;
#pragma unroll
    for (int c = 0; c < 2; ++c)
#pragma unroll
        for (int nt = 0; nt < 8; ++nt)
#pragma unroll
            for (int r = 0; r < 4; ++r) sl[(2 * (16 * wave + 4 * g + r) + c) * 129 + 16 * nt + n] = acc[c][nt][r];
    __syncthreads();
    {
        const int row = tid >> 1, hf = tid & 1, c = row & 1, tt = row >> 1;
        const LAS float* sr = sl + row * 129 + 64 * hf;
        int ta[16], tb2[16];
#pragma unroll
        for (int k = 0; k < 16; ++k) { ta[k] = (int)0x80000000; tb2[k] = (int)0x80000000; }
#pragma unroll 4
        for (int j = 0; j < 64; j += 2) { const int ka = (ord_key(sr[j]) & ~127) | (127 - (64 * hf + j)), kb = (ord_key(sr[j + 1]) & ~127) | (127 - (64 * hf + j + 1)); KINS16(ta, ka); KINS16(tb2, kb); }
        KMERGE16(ta, tb2);
#pragma unroll
        for (int k = 0; k < 16; ++k) tb2[k] = __shfl_xor(ta[k], 1);
        KMERGE16(ta, tb2);
        if (hf == 0) { v4u w;
#pragma unroll
            for (int e = 0; e < 4; ++e) w[e] = (unsigned)(127 - (ta[4 * e] & 127)) | ((unsigned)(127 - (ta[4 * e + 1] & 127)) << 8) | ((unsigned)(127 - (ta[4 * e + 2] & 127)) << 16) | ((unsigned)(127 - (ta[4 * e + 3] & 127)) << 24);
            *(LAS v4u*)(lds + P7_IL + row * 16) = w; }
#pragma unroll
        for (int k = 0; k < 16; ++k) tb2[k] = __shfl_xor(ta[k], 2);
        float s0[16], s1[16];
#pragma unroll
        for (int k = 0; k < 16; ++k) { s0[k] = ord_val(c ? tb2[k] : ta[k]); s1[k] = ord_val(c ? ta[k] : tb2[k]); }
        int ca[16], cb[16];
#pragma unroll
        for (int k = 0; k < 16; ++k) { ca[k] = (int)0x80000000; cb[k] = (int)0x80000000; }
        int cnt = 0;
#pragma unroll
        for (int a = 0; a < 16; ++a)
#pragma unroll
            for (int bq = 0; bq < 16; ++bq) if ((a + 1) * (bq + 1) <= 16) { const int kk = (ord_key(s0[a] + s1[bq]) & ~255) | (255 - (16 * a + bq));
                if (a == 0) { ca[bq] = kk; }
                else { if (cnt & 1) { KINS16(cb, kk); } else { KINS16(ca, kk); } ++cnt; } }
        KMERGE16(ca, cb);
        LDS_WAIT(); asm volatile("" ::: "memory");
        if ((tid & 3) == 0) {
            const LAS unsigned char* i0 = lds + P7_IL + (2 * tt) * 16; const LAS unsigned char* i1 = lds + P7_IL + (2 * tt + 1) * 16;
            const float mx = ord_val(ca[0]); float ev[16], sum = 0.f; int ex[16];
#pragma unroll
            for (int k = 0; k < 16; ++k) { ev[k] = __expf(ord_val(ca[k]) - mx); sum += ev[k]; const int flat = 255 - (ca[k] & 255); ex[k] = (int)i0[flat >> 4] * 128 + (int)i1[flat & 15]; }
            const float inv = 1.f / sum;
            int* eo = WSP(int, WS_EIDX) + (size_t)(t0 + tt) * 128 + h * 16; float* go = WSP(float, WS_EGATE) + (size_t)(t0 + tt) * 128 + h * 16;
#pragma unroll
            for (int k = 0; k < 16; ++k) { eo[k] = ex[k]; go[k] = ev[k] * inv; }
        }
    }
    __syncthreads();
}

typedef _Float16 h16x2 __attribute__((ext_vector_type(2)));
#define FP4_H2(word, sel) __builtin_amdgcn_cvt_scalef32_pk_f16_fp4((word), 1.0f, (sel))
__device__ __forceinline__ float gelu_erf(float v) {
    const float av = fabsf(v), t = __builtin_amdgcn_rcpf(av * 0.2316418882f + 1.0f);
    float q = t * 0.5307027145f + (-0.7265760135f); q = q * t + 0.7107068705f; q = q * t + (-0.142248368f); q = q * t + 0.127414796f; q = q * t;
    const float e = __builtin_amdgcn_exp2f((v * v) * (-0.72134752044f)), m = v * (q * e);
    return v < 0.f ? m : v - m;
}
__device__ __forceinline__ float group16_sum(float v) { v += dpp_f<0xB1>(v); v += dpp_f<0x4E>(v); v += dpp_f<0x141>(v); v += dpp_f<0x140>(v); return v; }
typedef int i32x4v __attribute__((ext_vector_type(4)));
typedef int i32x8v __attribute__((ext_vector_type(8)));
constexpr int P8_TROW = 288, P8_TILE = 32 * P8_TROW;
__device__ __forceinline__ void p8_dots_mfma(const unsigned char* tus, const LAS int* eiw, const unsigned char* xrow8, LAS float* hl, LAS unsigned char* tl, int lane) {
    const int m = lane & 15, kb = lane >> 4;
    i32x8v xb[4];
#pragma unroll
    for (int ks = 0; ks < 4; ++ks) { const i32x4v xlo = *(const i32x4v*)(xrow8 + 128 * ks + 16 * kb), xhi = *(const i32x4v*)(xrow8 + 128 * ks + 64 + 16 * kb); xb[ks] = __builtin_shufflevector(xlo, xhi, 0, 1, 2, 3, 4, 5, 6, 7); }
    const int one = 0x7F7F7F7F;
    i32x4v nd[8], nsc;
#define P8_TFETCH(T) do { _Pragma("unroll") for (int i_ = 0; i_ < 8; ++i_) nd[i_] = *(const i32x4v*)(tus + (size_t)eiw[2 * (32 * (T) + 4 * i_ + kb)] * XSL + 16 * m); \
        nsc = *(const i32x4v*)(tus + (size_t)eiw[2 * (32 * (T) + (lane & 31))] * XSL + 256); } while (0)
    P8_TFETCH(0);
#pragma unroll
    for (int T = 0; T < 4; ++T) {
#pragma unroll
        for (int i = 0; i < 8; ++i) *(LAS i32x4v*)(tl + (4 * i + kb) * P8_TROW + 16 * m) = nd[i];
        if (lane < 32) *(LAS i32x4v*)(tl + lane * P8_TROW + 256) = nsc;
        if (T < 3) P8_TFETCH(T + 1);
        LDS_WAIT(); asm volatile("" ::: "memory");
        f32x4 acc0 = (f32x4){0.f, 0.f, 0.f, 0.f}, acc1 = acc0;
#pragma unroll
        for (int ks = 0; ks < 4; ++ks) {
            const i32x4v p0 = *(const LAS i32x4v*)(tl + m * P8_TROW + 64 * ks + 16 * kb), p1 = *(const LAS i32x4v*)(tl + (16 + m) * P8_TROW + 64 * ks + 16 * kb);
            const unsigned s0 = *(const LAS unsigned*)(tl + m * P8_TROW + 256 + 4 * ks), s1 = *(const LAS unsigned*)(tl + (16 + m) * P8_TROW + 256 + 4 * ks);
            const int sa0 = (int)(((s0 >> (8 * kb)) & 0xffu) * 0x01010101u), sa1 = (int)(((s1 >> (8 * kb)) & 0xffu) * 0x01010101u);
            asm volatile("s_nop 1\n\tv_mfma_scale_f32_16x16x128_f8f6f4 %0, %1, %2, %0, %3, %4 op_sel_hi:[0,0,0] cbsz:4" : "+v"(acc0) : "v"(p0), "v"(xb[ks]), "v"(sa0), "v"(one));
            asm volatile("s_nop 1\n\tv_mfma_scale_f32_16x16x128_f8f6f4 %0, %1, %2, %0, %3, %4 op_sel_hi:[0,0,0] cbsz:4" : "+v"(acc1) : "v"(p1), "v"(xb[ks]), "v"(sa1), "v"(one));
        }
        asm volatile("s_nop 15\n\ts_nop 15\n\ts_nop 15" : "+v"(acc0), "+v"(acc1));
        if (m == 0) {
            LAS f32x4* hp0 = (LAS f32x4*)(hl + 32 * T + 4 * kb); *hp0 = *hp0 + acc0;
            LAS f32x4* hp1 = (LAS f32x4*)(hl + 32 * T + 16 + 4 * kb); *hp1 = *hp1 + acc1; }
        LDS_WAIT(); asm volatile("" ::: "memory");
    }
#undef P8_TFETCH
}
__device__ __forceinline__ void p8_axpy(const unsigned char* tvs, const LAS v2u* eaw, h16x2 (&acc)[16], int lane) {
    const int j = lane & 15, g = lane >> 4;
#pragma unroll 1
    for (int b8 = 0; b8 < 4; ++b8) {
        v4u w[8]; unsigned sc[8]; float av[8];
#pragma unroll
        for (int q = 0; q < 8; ++q) { const int i = 8 * b8 + q; const v2u ea = eaw[(i >= 16 ? 64 : 0) + 4 * (i & 15) + g]; av[q] = __uint_as_float(ea.y);
            const unsigned char* rp = tvs + (size_t)ea.x * XSL; w[q] = *(const v4u*)(rp + 16 * j); sc[q] = rp[256 + j]; }
#pragma unroll
        for (int q = 0; q < 8; ++q) { const _Float16 as = (_Float16)(av[q] * __uint_as_float(sc[q] << 23)); const h16x2 asv = (h16x2){as, as};
#pragma unroll
            for (int c = 0; c < 4; ++c) { acc[4 * c + 0] = FP4_H2(w[q][c], 0) * asv + acc[4 * c + 0]; acc[4 * c + 1] = FP4_H2(w[q][c], 1) * asv + acc[4 * c + 1];
                acc[4 * c + 2] = FP4_H2(w[q][c], 2) * asv + acc[4 * c + 2]; acc[4 * c + 3] = FP4_H2(w[q][c], 3) * asv + acc[4 * c + 3]; } }
    }
}
__device__ __forceinline__ size_t p8_out_off(int t, int s, int lane) { return (size_t)t * DM + 512 * s + 32 * (lane & 15) + 8 * (lane >> 4); }
__device__ __forceinline__ void p8_out(float* outbase, const v4u xb, int t, int s, int lane, h16x2 (&acc)[16]) {
    const int j = lane & 15, g = lane >> 4;
#pragma unroll
    for (int c = 0; c < 16; ++c) { union { h16x2 h; int i; } u, v; u.h = acc[c]; v.i = __shfl_xor(u.i, 16); u.h = u.h + v.h; v.i = __shfl_xor(u.i, 32); acc[c] = u.h + v.h; }
    h16x2 q[4];
#pragma unroll
    for (int c = 0; c < 4; ++c) q[c] = g == 0 ? acc[c] : (g == 1 ? acc[4 + c] : (g == 2 ? acc[8 + c] : acc[12 + c]));
    f32x4* op = (f32x4*)(outbase + p8_out_off(t, s, lane));
    op[0] = (f32x4){bflo(xb.x), bfhi(xb.x), bflo(xb.y), bfhi(xb.y)} + (f32x4){(float)q[0][0], (float)q[0][1], (float)q[1][0], (float)q[1][1]};
    op[1] = (f32x4){bflo(xb.z), bfhi(xb.z), bflo(xb.w), bfhi(xb.w)} + (f32x4){(float)q[2][0], (float)q[2][1], (float)q[3][0], (float)q[3][1]};
}
__device__ __forceinline__ void p8_wave(const Params& p, LAS unsigned char* wlds, int t0, int tstride, int lane, float* outbase) {
    const int j = lane & 15, g4 = lane >> 4;
    const unsigned char* TU = WSP(const unsigned char, WS_U8); const unsigned char* TV = WSP(const unsigned char, WS_V8);
    LAS v2u* ea = (LAS v2u*)wlds;
    float rs[4];
#pragma unroll
    for (int q = 0; q < 4; ++q) { const int t = t0 + q * tstride; const int tt = t < NT ? t : t0;
        const int* ei = WSP(const int, WS_EIDX) + (size_t)tt * 128;
        ea[q * 128 + lane] = (v2u){(unsigned)ei[lane], 0u}; ea[q * 128 + 64 + lane] = (v2u){(unsigned)ei[64 + lane], 0u};
        rs[q] = rsqrtf(wave_sum_dpp(WSP(const float, WS_PART)[(size_t)tt * 64 + lane]) * (1.f / 4096.f) + EPS); }
    LDS_WAIT(); asm volatile("" ::: "memory");
    LAS float* hl = (LAS float*)(wlds + 4096);
#pragma unroll
    for (int q = 0; q < 8; ++q) hl[64 * q + lane] = 0.f;
    LDS_WAIT(); asm volatile("" ::: "memory");
#pragma unroll 1
    for (int s = 0; s < 8; ++s) {
        const unsigned char* tus = TU + (size_t)s * XSLICE;
#pragma unroll
        for (int q = 0; q < 4; ++q) { const int t = t0 + q * tstride; p8_dots_mfma(tus, (const LAS int*)(wlds + q * 1024), WSP(const unsigned char, WS_XN8) + (size_t)(t < NT ? t : t0) * DM + 512 * s, hl + 128 * q, wlds + 6144, lane); }
    }
    LDS_WAIT(); asm volatile("" ::: "memory");
#pragma unroll
    for (int q = 0; q < 4; ++q) { const int t = t0 + q * tstride; const bool ok = t < NT; const float* eg = WSP(const float, WS_EGATE) + (size_t)(ok ? t : t0) * 128;
#pragma unroll
        for (int hh = 0; hh < 2; ++hh) { const int slot = 64 * hh + lane; const float a = ok ? gelu_erf(hl[128 * q + slot] * rs[q]) * eg[slot] : 0.f; ((LAS unsigned*)ea)[2 * (q * 128 + slot) + 1] = __float_as_uint(a); } }
    LDS_WAIT(); asm volatile("" ::: "memory");
#pragma unroll 1
    for (int s = 0; s < 8; ++s) {
        const unsigned char* tvs = TV + (size_t)s * XSLICE;
#pragma unroll
        for (int q = 0; q < 4; ++q) { const int t = t0 + q * tstride;
            h16x2 acc[16];
#pragma unroll
            for (int c = 0; c < 16; ++c) acc[c] = (h16x2){(_Float16)0.f, (_Float16)0.f};
            const v4u xb = *(const v4u*)(WSP(const bf16, WS_X1B) + p8_out_off(t < NT ? t : t0, s, lane));
            p8_axpy(tvs, ea + q * 128, acc, lane);
            if (t < NT) p8_out(outbase, xb, t, s, lane, acc); }
    }
    LDS_WAIT(); asm volatile("" ::: "memory");
}

#define CAS __attribute__((address_space(4)))
template <class T> __device__ __forceinline__ T* as_global(T* q) { GAS T* g = (GAS T*)q; asm volatile("" : "+s"(g)); return (T*)g; }
__device__ __forceinline__ Params load_params(const CAS char* kp) {
#if defined(__HIP_DEVICE_COMPILE__)
    unsigned off = 0; asm volatile("" : "+s"(off));
    const CAS unsigned long long* q = (const CAS unsigned long long*)(kp + off);
    union { Params p; unsigned long long w[sizeof(Params) / 8]; } u;
#pragma unroll
    for (int i = 0; i < (int)(sizeof(Params) / 8); ++i) u.w[i] = q[i];
    Params r = u.p;
#define GLOBALIZE(f) r.f = as_global(r.f)
    GLOBALIZE(x); GLOBALIZE(mem); GLOBALIZE(pos); GLOBALIZE(ln1_g); GLOBALIZE(w_in); GLOBALIZE(att_q_g); GLOBALIZE(att_k_g); GLOBALIZE(rel_bias); GLOBALIZE(mem_g); GLOBALIZE(w_mem_kv); GLOBALIZE(mem_q_g);
    GLOBALIZE(mem_k_g); GLOBALIZE(w_up_ret); GLOBALIZE(w_up_att); GLOBALIZE(w_up_mem); GLOBALIZE(w_out); GLOBALIZE(ln2_g); GLOBALIZE(peer_w_q); GLOBALIZE(peer_sub_keys); GLOBALIZE(peer_u); GLOBALIZE(peer_v);
    GLOBALIZE(out); GLOBALIZE(ws);
#undef GLOBALIZE
    return r;
#else
    return Params{};
#endif
}
static_assert(sizeof(Params) % 8 == 0, "Params is a whole number of 8-byte words");
#define PP() load_params(kp)
__global__ void __launch_bounds__(NTHR, 2) fwd(Params p_arg) {
    const CAS char* kp = (const CAS char*)__builtin_amdgcn_kernarg_segment_ptr();
    extern __shared__ __attribute__((aligned(16))) unsigned char lds_raw[];
    LAS unsigned char* lds = (LAS unsigned char*)lds_raw;
    const int tid = threadIdx.x, lane = tid & 63, wave = __builtin_amdgcn_readfirstlane(tid >> 6);
    if (tid < 64) ((LAS unsigned*)(lds + LDSCTL_OFF))[tid] = 0u;
    __syncthreads();
    XcdBarrier bar; int lo, hi;
    { const Params p = PP(); bar = xcd_barrier_post(WSP(unsigned, WS_CTL) + CW_BAR + p.li * XCD_BAR_WORDS, (volatile LAS unsigned*)(lds + LDSCTL_OFF)); lo = p.ph_lo; hi = p.ph_hi; }
#if defined(SKIP_MASK)
#define IN(k) (!((SKIP_MASK >> (k)) & 1) && lo <= (k) && (k) < hi)
#elif defined(ONLY_PH)
#define IN(k) ((k) == ONLY_PH && lo <= (k) && (k) < hi)
#else
#define IN(k) (lo <= (k) && (k) < hi)
#endif
#define SEAM(k) do { if (IN(k) && IN((k) + 1)) xcd_barrier(bar); } while (0)
#ifndef REPEAT_MASK
#define REPEAT_MASK 0
#endif
#define REPS(k) for (int rep_ = 0; rep_ < ((((REPEAT_MASK) >> (k)) & 1) ? 2 : 1); ++rep_)
#define REPBAR() do { if (rep_) xcd_barrier(bar); } while (0)
    if (IN(0)) REPS(0) { REPBAR(); const Params p = PP(); phase0(p, lds, tid, wave, lane); }
    SEAM(0);
    if (IN(1)) REPS(1) { REPBAR();
        const Params p = PP();
        { pg8::Gemm g{WSP(const pg8::bf16_t, WS_R8), WSP(const pg8::bf16_t, WS_R8), 8192, 22016, 4096}; pg8::OrderP1b S; S.init((int)gridDim.x, (int)blockIdx.x);
          LAS unsigned char* lut = lds + 131072;
          for (int i = tid; i < 4097; i += NTHR) lut[i] = (unsigned char)pg8::EpiP1b::sig_u8_exact(-8.f + (float)i * (1.f / 256.f));
          __syncthreads();
          pg8::EpiP1b E{WSP(pg8::bf16_t, WS_PROJ), WSP(pg8::bf16_t, WS_MK), WSP(pg8::bf16_t, WS_MVT), WSP(unsigned char, WS_SG), lut};
          pg8::gemm_phase_f8<pg8::EpiP1b, pg8::OrderP1b, true, true>(lds, g, S, E); }
    }
    SEAM(1);
    if (IN(2)) REPS(2) { REPBAR(); const Params p = PP(); phase2a(p, lds, tid, wave, lane); }
    SEAM(2);
    if (IN(3)) REPS(3) { REPBAR(); const Params p = PP(); phase2b(p, lds, tid, wave, lane); }
    SEAM(3);
    if (IN(4)) REPS(4) { REPBAR(); const Params p = PP(); phase2c(p, lds, tid, wave, lane); }
    SEAM(4);
    if (IN(5)) REPS(5) { REPBAR();
        const Params p = PP();
        pg8::Gemm g{WSP(const pg8::bf16_t, WS_Y), WSP(const pg8::bf16_t, WS_WUP), 8192, 4096, 4096}; pg8::OrderUp S; S.init((int)gridDim.x, (int)blockIdx.x);
        pg8::EpiUp E{WSP(const unsigned char, WS_SG), WSP(pg8::bf16_t, WS_MERGED), {}};
        pg8::gemm_phase<pg8::EpiUp, pg8::OrderUp, true, true>(lds, g, S, E);
    }
    SEAM(5);
    if (IN(6)) REPS(6) { REPBAR();
        const Params p = PP();
        pg8::Gemm g{WSP(const pg8::bf16_t, WS_MERGED), WSP(const pg8::bf16_t, WS_WOUT), 8192, 4096, 4096}; pg8::StaticOrder S; S.init(8192, 4096, (int)gridDim.x, (int)blockIdx.x);
        pg8::EpiResF32 E{p.x, WSP(pg8::bf16_t, WS_X1B), WSP(float, WS_PART), WSP(unsigned char, WS_XN8)};
        pg8::gemm_phase<pg8::EpiResF32, pg8::StaticOrder, true, true>(lds, g, S, E);
    }
    do { if (IN(6) && IN(8)) xcd_barrier(bar); } while (0);
    if (IN(8)) REPS(8) { REPBAR();
        const Params p = PP();
        pg8::Gemm g{WSP(const pg8::bf16_t, WS_X1B), WSP(const pg8::bf16_t, WS_WQ), 8192, 2048, 4096}; pg8::StaticOrder S; S.init(8192, 2048, (int)gridDim.x, (int)blockIdx.x);
        pg8::EpiStoreBf16Rs E{WSP(pg8::bf16_t, WS_QP), 2048, WSP(const float, WS_PART)};
        pg8::gemm_phase<pg8::EpiStoreBf16Rs, pg8::StaticOrder, true, true>(lds, g, S, E);
    }
    if (IN(9)) {
        const Params p = PP();
        const bool own = IN(8) && gridDim.x == 256;
        if (IN(8) && !own) xcd_barrier(bar);
        int base = (int)blockIdx.x, stride = (int)gridDim.x, cnt = (512 - base + stride - 1) / stride;
        if (own) {
            __builtin_amdgcn_fence(__ATOMIC_RELEASE, "workgroup"); __syncthreads(); __builtin_amdgcn_fence(__ATOMIC_ACQUIRE, "workgroup");
            pg8::StaticOrder S; S.init(8192, 2048, (int)gridDim.x, (int)blockIdx.x); pg8::Unit u; S.next(0, u);
            base = __builtin_amdgcn_readfirstlane(2 * u.pm * 8 + u.pn); stride = 8; cnt = 2;
        }
#pragma unroll 1
        for (int j = 0; j < cnt; ++j) p7_item(p, lds, base + j * stride, tid, wave, lane);
    }
    SEAM(9);
    if (IN(10)) REPS(10) { REPBAR(); const Params p = PP(); const int gw = blockIdx.x * NWAVES + wave, NGW = gridDim.x * NWAVES;
        for (int t0 = gw; t0 < NT; t0 += 4 * NGW) p8_wave(p, lds + wave * 15360, t0, NGW, lane, (((REPEAT_MASK) >> 10) & 1) && rep_ == 0 ? WSP(float, WS_R) : p.out); }
#undef IN
#undef SEAM
}

extern "C" void kernel_launch(void* const* d_in, const int* in_sizes, int n_in, void* d_out, int out_size, void* d_ws, size_t ws_size, hipStream_t stream) {
    static int grid = 0;
    if (grid == 0) {
        if (n_in != 21 || out_size != NT * DM || ws_size < WS_END) { fprintf(stderr, "kernel_launch: unexpected shapes (n_in %d, out %d, ws %zu)\n", n_in, out_size, ws_size); grid = -1; return; }
        int dev = 0, cus = 0, per_cu = 0;
        if (hipGetDevice(&dev) != hipSuccess || hipDeviceGetAttribute(&cus, hipDeviceAttributeMultiprocessorCount, dev) != hipSuccess) { grid = -1; return; }
        if (hipFuncSetAttribute((const void*)fwd, hipFuncAttributeMaxDynamicSharedMemorySize, LDS_BYTES) != hipSuccess) { fprintf(stderr, "kernel_launch: hipFuncSetAttribute failed\n"); grid = -1; return; }
        if (hipOccupancyMaxActiveBlocksPerMultiprocessor(&per_cu, (const void*)fwd, NTHR, LDS_BYTES) != hipSuccess || per_cu < 1) fprintf(stderr, "kernel_launch: occupancy query reports %d workgroups per CU\n", per_cu);
        (void)hipGetLastError();
        grid = cus;
    }
    if (grid < 0) return;
    if (hipMemsetAsync((char*)d_ws + WS_CTL, 0, CTL_ZERO_BYTES, stream) != hipSuccess) return;
    Params p{};
    p.x = (const float*)d_in[0]; p.mem = (const float*)d_in[1]; p.pos = (const int*)d_in[2]; p.ln1_g = (const float*)d_in[3]; p.w_in = (const float*)d_in[4];
    p.att_q_g = (const float*)d_in[5]; p.att_k_g = (const float*)d_in[6]; p.rel_bias = (const float*)d_in[7]; p.mem_g = (const float*)d_in[8]; p.w_mem_kv = (const float*)d_in[9];
    p.mem_q_g = (const float*)d_in[10]; p.mem_k_g = (const float*)d_in[11]; p.w_up_ret = (const float*)d_in[12]; p.w_up_att = (const float*)d_in[13]; p.w_up_mem = (const float*)d_in[14];
    p.w_out = (const float*)d_in[15]; p.ln2_g = (const float*)d_in[16]; p.peer_w_q = (const float*)d_in[17]; p.peer_sub_keys = (const float*)d_in[18]; p.peer_u = (const float*)d_in[19]; p.peer_v = (const float*)d_in[20];
    p.out = (float*)d_out; p.ws = (unsigned char*)d_ws; p.pad = 0;
#if MK_PER_PHASE
    for (int li = 0; li < NPH; ++li) { p.ph_lo = li; p.ph_hi = li + 1; p.li = li; hipLaunchKernelGGL(fwd, dim3(grid), dim3(NTHR), LDS_BYTES, stream, p); }
#else
    p.ph_lo = 0; p.ph_hi = NPH; p.li = 0; hipLaunchKernelGGL(fwd, dim3(grid), dim3(NTHR), LDS_BYTES, stream, p);
#endif
}
```
